# Optimizing an MI355X kernel written in HIP

```python
import jax, jax.numpy as jnp
from jax import lax
import numpy as np

D_MODEL = 1024
BATCH = 4
SEQ = 4096
DEPTH = 2

BLOCK_Q = 128
EPS = 1e-6
NEG_INF = -1e30
ROPE_THETA = 10000.0

MLA_HEADS = 8
MLA_Q_RANK = 256
MLA_KV_RANK = 128
MLA_NOPE = 64
MLA_ROPE = 32
MLA_QK = MLA_NOPE + MLA_ROPE
MLA_V = 64
SB_HEADS = 8
SB_DIM = 64
SB_WIDTH = SB_HEADS * SB_DIM
FOX_HEADS = 16
FOX_DIM = 64
FOX_WIDTH = FOX_HEADS * FOX_DIM
D_FF = ((8 * D_MODEL // 3 + 255) // 256) * 256

EVEN_IN = MLA_Q_RANK + MLA_KV_RANK + MLA_ROPE + 3 * SB_WIDTH
EVEN_OUT = MLA_HEADS * MLA_V + SB_WIDTH
ODD_IN = 3 * FOX_WIDTH + FOX_HEADS
ODD_OUT = FOX_WIDTH

kernel_name = 'hybrid_mla_stickbreaking_fox_block'


def rms_norm(x, g):
    xf = x.astype(jnp.float32)
    y = xf * lax.rsqrt(jnp.mean(xf * xf, axis=-1, keepdims=True) + EPS)
    return (y * g.astype(jnp.float32)).astype(x.dtype)


def split_last(x, sizes):
    return jnp.split(x, [int(v) for v in np.cumsum(sizes)[:-1]], axis=-1)


def heads_first(x):
    return x.transpose(0, 2, 1, 3)


def merge_heads(x):
    b, h, s, d = x.shape
    return x.transpose(0, 2, 1, 3).reshape(b, s, h * d)


def rope_tail(x, positions):
    nope, r = x[..., :-MLA_ROPE], x[..., -MLA_ROPE:]
    half = MLA_ROPE // 2
    inv_freq = ROPE_THETA ** (-jnp.arange(half, dtype=jnp.float32) / half)
    ang = positions.astype(jnp.float32)[..., None] * inv_freq
    cos, sin = jnp.cos(ang)[:, :, None, :], jnp.sin(ang)[:, :, None, :]
    r1, r2 = r[..., :half].astype(jnp.float32), r[..., half:].astype(jnp.float32)
    rot = jnp.concatenate([r1 * cos - r2 * sin, r2 * cos + r1 * sin], axis=-1)
    return jnp.concatenate([nope, rot.astype(x.dtype)], axis=-1)


def sweep_query_blocks(block_fn, q):
    b, h, s, _ = q.shape
    out = lax.map(block_fn, jnp.arange(s // BLOCK_Q))
    nb, _, _, bq, dv = out.shape
    return out.transpose(1, 2, 0, 3, 4).reshape(b, h, nb * bq, dv)


def causal_softmax_attention(q, k, v, scale, decay=None):
    s = k.shape[2]
    k_idx = jnp.arange(s)

    def block(i):
        start = i * BLOCK_Q
        qb = lax.dynamic_slice_in_dim(q, start, BLOCK_Q, axis=2)
        logits = jnp.einsum('bhqd,bhkd->bhqk', qb, k).astype(jnp.float32) * scale
        if decay is not None:
            cq = lax.dynamic_slice_in_dim(decay, start, BLOCK_Q, axis=2)
            logits = logits + cq[..., :, None] - decay[..., None, :]
        q_idx = start + jnp.arange(BLOCK_Q)
        mask = k_idx[None, :] <= q_idx[:, None]
        p = jax.nn.softmax(jnp.where(mask, logits, NEG_INF), axis=-1)
        return jnp.einsum('bhqk,bhkd->bhqd', p.astype(v.dtype), v)

    return sweep_query_blocks(block, q)


def stick_breaking_attention(q, k, v):
    s = k.shape[2]
    scale = q.shape[-1] ** -0.5
    k_idx = jnp.arange(s)

    def block(i):
        start = i * BLOCK_Q
        qb = lax.dynamic_slice_in_dim(q, start, BLOCK_Q, axis=2)
        z = jnp.einsum('bhqd,bhkd->bhqk', qb, k).astype(jnp.float32) * scale
        q_idx = start + jnp.arange(BLOCK_Q)
        mask = k_idx[None, :] < q_idx[:, None]
        log_beta = jax.nn.log_sigmoid(z)
        log_1m_beta = jnp.where(mask, jax.nn.log_sigmoid(-z), 0.0)
        suffix = lax.cumsum(log_1m_beta, axis=3, reverse=True) - log_1m_beta
        a = jnp.where(mask, jnp.exp(log_beta + suffix), 0.0)
        return jnp.einsum('bhqk,bhkd->bhqd', a.astype(v.dtype), v)

    return sweep_query_blocks(block, q)


def even_mixer(h, positions, w_in, q_a_norm, w_q_up, kv_a_norm, w_kv_up, q_norm, k_norm, w_o):
    b, s, _ = h.shape
    proj = h @ w_in
    cq, ckv, k_rope, sb_qkv = split_last(proj, [MLA_Q_RANK, MLA_KV_RANK, MLA_ROPE, 3 * SB_WIDTH])
    q = (rms_norm(cq, q_a_norm) @ w_q_up).reshape(b, s, MLA_HEADS, MLA_QK)
    kv = (rms_norm(ckv, kv_a_norm) @ w_kv_up).reshape(b, s, MLA_HEADS, MLA_NOPE + MLA_V)
    k_nope, v = kv[..., :MLA_NOPE], kv[..., MLA_NOPE:]
    k_rope = jnp.broadcast_to(k_rope[:, :, None, :], (b, s, MLA_HEADS, MLA_ROPE))
    k = jnp.concatenate([k_nope, k_rope], axis=-1)
    q = rope_tail(rms_norm(q, q_norm), positions)
    k = rope_tail(rms_norm(k, k_norm), positions)
    mla = causal_softmax_attention(heads_first(q), heads_first(k), heads_first(v), MLA_QK ** -0.5)
    sq, sk, sv = [heads_first(t.reshape(b, s, SB_HEADS, SB_DIM)) for t in jnp.split(sb_qkv, 3, axis=-1)]
    sb = stick_breaking_attention(sq, sk, sv)
    o = jnp.concatenate([merge_heads(mla), merge_heads(sb)], axis=-1)
    return o @ w_o


def odd_mixer(h, w_in, f_bias, q_norm, k_norm, w_o):
    b, s, _ = h.shape
    proj = h @ w_in
    q, k, v, f_logit = split_last(proj, [FOX_WIDTH, FOX_WIDTH, FOX_WIDTH, FOX_HEADS])
    q = rms_norm(q.reshape(b, s, FOX_HEADS, FOX_DIM), q_norm)
    k = rms_norm(k.reshape(b, s, FOX_HEADS, FOX_DIM), k_norm)
    v = v.reshape(b, s, FOX_HEADS, FOX_DIM)
    log_f = jax.nn.log_sigmoid(f_logit.astype(jnp.float32) + f_bias.astype(jnp.float32))
    decay = lax.cumsum(log_f, axis=1).transpose(0, 2, 1)
    o = causal_softmax_attention(heads_first(q), heads_first(k), heads_first(v), FOX_DIM ** -0.5, decay)
    return merge_heads(o) @ w_o


def swiglu(h, w_gate, w_up, w_down):
    return (jax.nn.silu(h @ w_gate) * (h @ w_up)) @ w_down


def setup_inputs(seed: int = 0) -> dict:
    key = jax.random.key(seed)
    ks = iter(jax.random.split(key, 32))

    def dense(shape):
        return jax.random.normal(next(ks), shape, jnp.float32) * shape[0] ** -0.5

    def gain(n):
        return 1.0 + 0.1 * jax.random.normal(next(ks), (n,), jnp.float32)

    x = jax.random.normal(next(ks), (BATCH, SEQ, D_MODEL), jnp.float32)
    offsets = jax.random.randint(next(ks), (BATCH, 1), 0, SEQ, dtype=jnp.int32)
    positions = (offsets + jnp.arange(SEQ, dtype=jnp.int32)[None, :]).astype(jnp.int32)
    return {
        'x': x,
        'positions': positions,
        'l0_attn_norm': gain(D_MODEL),
        'l0_w_in': dense((D_MODEL, EVEN_IN)),
        'l0_mla_q_a_norm': gain(MLA_Q_RANK),
        'l0_mla_w_q_up': dense((MLA_Q_RANK, MLA_HEADS * MLA_QK)),
        'l0_mla_kv_a_norm': gain(MLA_KV_RANK),
        'l0_mla_w_kv_up': dense((MLA_KV_RANK, MLA_HEADS * (MLA_NOPE + MLA_V))),
        'l0_mla_q_norm': gain(MLA_QK),
        'l0_mla_k_norm': gain(MLA_QK),
        'l0_w_o': dense((EVEN_OUT, D_MODEL)),
        'l0_ffn_norm': gain(D_MODEL),
        'l0_w_gate': dense((D_MODEL, D_FF)),
        'l0_w_up': dense((D_MODEL, D_FF)),
        'l0_w_down': dense((D_FF, D_MODEL)),
        'l1_attn_norm': gain(D_MODEL),
        'l1_w_in': dense((D_MODEL, ODD_IN)),
        'l1_fox_f_bias': 3.0 + 0.5 * jax.random.normal(next(ks), (FOX_HEADS,), jnp.float32),
        'l1_fox_q_norm': gain(FOX_DIM),
        'l1_fox_k_norm': gain(FOX_DIM),
        'l1_w_o': dense((ODD_OUT, D_MODEL)),
        'l1_ffn_norm': gain(D_MODEL),
        'l1_w_gate': dense((D_MODEL, D_FF)),
        'l1_w_up': dense((D_MODEL, D_FF)),
        'l1_w_down': dense((D_FF, D_MODEL)),
    }


def reference(x, positions,
              l0_attn_norm, l0_w_in, l0_mla_q_a_norm, l0_mla_w_q_up, l0_mla_kv_a_norm,
              l0_mla_w_kv_up, l0_mla_q_norm, l0_mla_k_norm, l0_w_o,
              l0_ffn_norm, l0_w_gate, l0_w_up, l0_w_down,
              l1_attn_norm, l1_w_in, l1_fox_f_bias, l1_fox_q_norm, l1_fox_k_norm, l1_w_o,
              l1_ffn_norm, l1_w_gate, l1_w_up, l1_w_down):
    mixer_params = (
        (l0_attn_norm, l0_w_in, l0_mla_q_a_norm, l0_mla_w_q_up, l0_mla_kv_a_norm,
         l0_mla_w_kv_up, l0_mla_q_norm, l0_mla_k_norm, l0_w_o),
        (l1_attn_norm, l1_w_in, l1_fox_f_bias, l1_fox_q_norm, l1_fox_k_norm, l1_w_o),
    )
    ffn_params = (
        (l0_ffn_norm, l0_w_gate, l0_w_up, l0_w_down),
        (l1_ffn_norm, l1_w_gate, l1_w_up, l1_w_down),
    )
    for layer in range(DEPTH):
        norm_g, *mp = mixer_params[layer]
        h = rms_norm(x, norm_g)
        if layer % 2 == 0:
            x = x + even_mixer(h, positions, *mp)
        else:
            x = x + odd_mixer(h, *mp)
        f_norm, w_gate, w_up, w_down = ffn_params[layer]
        x = x + swiglu(rms_norm(x, f_norm), w_gate, w_up, w_down)
    return x
```

```cpp
#include <hip/hip_runtime.h>
#include <cstdio>
#include <cstdint>
#include <cmath>

#ifndef MK_N_LAUNCHES
#define MK_N_LAUNCHES 1
#endif

namespace pg8 {
#define PG8_LAS __attribute__((address_space(3)))
typedef unsigned short bf16_t;
typedef short bf16x8 __attribute__((ext_vector_type(8)));
typedef float f32x4 __attribute__((ext_vector_type(4)));
typedef unsigned u32x4 __attribute__((ext_vector_type(4)));
typedef unsigned u32x2 __attribute__((ext_vector_type(2)));
constexpr int BM = 256, BK = 64, HALF = 128, HTB = HALF * BK * 2, STAGE_BYTES = 8 * HTB, NXCD = 8, WGM = 8;
#ifndef MK_WT
#define MK_WT 0
#endif
__device__ __forceinline__ void st16(void* p, u32x4 v) {
#if MK_WT
    asm volatile("global_store_dwordx4 %0, %1, off sc1\n\ts_nop 1" :: "v"(p), "v"(v) : "memory");
#else
    *(u32x4*)p = v;
#endif
}
__device__ __forceinline__ void st8(void* p, u32x2 v) {
#if MK_WT
    asm volatile("global_store_dwordx2 %0, %1, off sc1\n\ts_nop 1" :: "v"(p), "v"(v) : "memory");
#else
    *(u32x2*)p = v;
#endif
}

__host__ __device__ __forceinline__ int lds_byte(int r, int c) { const int st = (r >> 4) * 2 + (c >> 5), rr = r & 15, cc = c & 31, ob = rr * 64 + cc * 2; return st * 1024 + (ob ^ (((ob >> 9) & 1) << 5)); }
__host__ __device__ __forceinline__ void stage_rc(int b, int& R, int& C) { const int st = b / 1024, sb = b % 1024, swz = sb ^ (((sb >> 9) & 1) << 5); R = (st >> 1) * 16 + swz / 64; C = (st & 1) * 32 + (swz % 64) / 2; }
__host__ __device__ __forceinline__ int perm32(int rho) { const int n = rho >> 4, i = rho & 15; return 8 * (i >> 2) + 4 * n + (i & 3); }

struct Unit { int pm, pn, half; };
struct Gemm { const bf16_t* A; const bf16_t* Bt; int M, N, K, lda, split_pn, split_off; };

struct StaticOrder {
    int nM, nN, nwg, G, c;
    __host__ __device__ void init(int M, int N, int G_, int c_) { nM = M / BM; nN = N / BM; nwg = nM * nN; G = G_; c = c_; }
    __host__ __device__ bool next(int i, Unit& u) const {
        const long L = (long)i * G + c; if (L >= nwg) return false;
        int wgid = (int)L; { const int q = nwg / NXCD, r = nwg % NXCD, xcd = wgid % NXCD, off = wgid / NXCD; wgid = (xcd < r ? xcd * (q + 1) : r * (q + 1) + (xcd - r) * q) + off; }
        const int nig = WGM * nN, gid = wgid / nig, fm = gid * WGM, gsz = (nM - fm) < WGM ? (nM - fm) : WGM;
        u.pm = fm + ((wgid % nig) % gsz); u.pn = (wgid % nig) / gsz; u.half = 0; return true;
    }
};
struct HalfTailOrder : StaticOrder {
    __host__ __device__ bool next(int i, Unit& u) const {
        const int nfull = nwg / G;
        if (nwg - nfull * G != G / 2 || (G % 16) != 0) return StaticOrder::next(i, u);
        if (i < nfull) return StaticOrder::next(i, u);
        if (i > nfull) return false;
        const int k = c / NXCD, cc = (c % NXCD) + NXCD * (k >> 1);
        StaticOrder t = *this; t.c = cc; t.next(nfull, u); u.half = 1 + (k & 1); return true;
    }
};

__device__ __forceinline__ unsigned cvt_pk_bf16(float lo, float hi) { unsigned r; asm volatile("v_cvt_pk_bf16_f32 %0, %1, %2" : "=v"(r) : "v"(lo), "v"(hi)); return r; }
__device__ __forceinline__ float dot4(f32x4 v) { return (v[0] * v[0] + v[1] * v[1]) + (v[2] * v[2] + v[3] * v[3]); }
__device__ __forceinline__ float rs16(const float* ssq, int row, float invD) {
    const f32x4* p = (const f32x4*)(ssq + (size_t)row * 16); const f32x4 a = p[0], b = p[1], c = p[2], d = p[3];
    const float s = (((a[0] + a[1]) + (a[2] + a[3])) + ((b[0] + b[1]) + (b[2] + b[3]))) + (((c[0] + c[1]) + (c[2] + c[3])) + ((d[0] + d[1]) + (d[2] + d[3])));
    return __builtin_amdgcn_rsqf(s * invD + 1e-6f);
}
__device__ __forceinline__ float rs4(const float* ssq, int row, float invD) {
    const f32x4 a = *(const f32x4*)(ssq + (size_t)row * 4); return __builtin_amdgcn_rsqf(((a[0] + a[1]) + (a[2] + a[3])) * invD + 1e-6f);
}
__device__ __forceinline__ void rs8(const float* ssq, int row0, float invD, float (&rs)[8]) {
    f32x4 a[8];
#pragma unroll
    for (int i = 0; i < 8; ++i) a[i] = *(const f32x4*)(ssq + (size_t)(row0 + (i >> 2) * HALF + (i & 3) * 16) * 4);
#pragma unroll
    for (int i = 0; i < 8; ++i) rs[i] = __builtin_amdgcn_rsqf(((a[i][0] + a[i][1]) + (a[i][2] + a[i][3])) * invD + 1e-6f);
}
constexpr int SSQ_LDS_OFF = 131072 + 4096, SSQ_LDS_BYTES = 4096;
__device__ __forceinline__ void rs8_lds(const PG8_LAS unsigned char* ss, int rl0, float invD, float (&rs)[8]) {
    f32x4 a[8];
#pragma unroll
    for (int i = 0; i < 8; ++i) a[i] = *(const PG8_LAS f32x4*)(ss + (rl0 + (i >> 2) * HALF + (i & 3) * 16) * 16);
#pragma unroll
    for (int i = 0; i < 8; ++i) rs[i] = __builtin_amdgcn_rsqf(((a[i][0] + a[i][1]) + (a[i][2] + a[i][3])) * invD + 1e-6f);
}
__device__ __forceinline__ void rs4_lds(const PG8_LAS unsigned char* ss, int rl0, float invD, float (&rs)[4]) {
    f32x4 a[4];
#pragma unroll
    for (int i = 0; i < 4; ++i) a[i] = *(const PG8_LAS f32x4*)(ss + (rl0 + i * 16) * 16);
#pragma unroll
    for (int i = 0; i < 4; ++i) rs[i] = __builtin_amdgcn_rsqf(((a[i][0] + a[i][1]) + (a[i][2] + a[i][3])) * invD + 1e-6f);
}
template <int N> __device__ __forceinline__ void wait_v() { asm volatile("s_waitcnt vmcnt(%0)" :: "n"(N) : "memory"); }
constexpr int GAIN_LDS_OFF = SSQ_LDS_OFF + 2 * SSQ_LDS_BYTES;
__device__ __forceinline__ u32x4 pack8(f32x4 v0, f32x4 v1) { u32x4 w; w.x = cvt_pk_bf16(v0[0], v0[1]); w.y = cvt_pk_bf16(v0[2], v0[3]); w.z = cvt_pk_bf16(v1[0], v1[1]); w.w = cvt_pk_bf16(v1[2], v1[3]); return w; }
__device__ __forceinline__ size_t vimg_off(int bh, int s, int d) { return ((size_t)bh * 64 + (s >> 6)) * 4096 + (size_t)(((d >> 5) * 4 + ((s & 63) >> 4)) * 512 + (s & 15) * 32 + (d & 31)); }

struct EpiProj0 {
    static constexpr bool PERM = true, AFTER_DRAIN = false, SSQ_LDS = true, SPLIT = false;
    static constexpr int S0 = 0, S1 = 16;
    __device__ __forceinline__ const float* ssq_src(const Unit&) const { return ssqx; }
    bf16_t* O; bf16_t* SBK; bf16_t* SBV; const float* ssqx; float* ssq_cq; float* ssq_ckv; float* ssq_kr;
    __device__ __forceinline__ void init_lds(PG8_LAS unsigned char*, int) const {}
    __device__ __forceinline__ void wait_half0(const Unit& u, int wc) const { if (u.pn < 6) wait_v<6 + 8>(); else if (u.pn == 6 || wc != 0) wait_v<6 + 12>(); else wait_v<6 + 16>(); }
    template <int ai>
    __device__ __forceinline__ void half(const f32x4 (&acc)[2][2][4][2], const Unit& u, int wr, int wc, int fr_, int fq_, const PG8_LAS unsigned char* ss) const {
        int fr = fr_, fq = fq_; asm volatile("" : "+v"(fr), "+v"(fq));
        const int row0 = u.pm * BM + wr * 64 + fr, col0 = u.pn * BM + wc * 32 + 8 * fq;
        float rsv[4]; rs4_lds(ss, ai * HALF + wr * 64 + fr, 1.0f / 1024.0f, rsv);
#pragma unroll
            for (int m = 0; m < 4; ++m) {
                const int row = row0 + ai * HALF + m * 16; const float rs = rsv[m];
                float part[2];
#pragma unroll
                for (int bj = 0; bj < 2; ++bj) { const f32x4 v0 = acc[ai][bj][m][0] * rs, v1 = acc[ai][bj][m][1] * rs; part[bj] = dot4(v0) + dot4(v1);
                    if (u.pn == 2 || u.pn == 3) { const int cc = (u.pn - 2) * 256 + bj * HALF + wc * 32 + 8 * fq, hd = cc >> 6, ch = (cc & 63) >> 3;
                        st16(SBK + ((size_t)((row >> 12) * 8 + hd) * 64 + ((row & 4095) >> 6)) * 4096 + (size_t)ch * 512 + (size_t)(row & 63) * 8, pack8(v0, v1)); }
                    else if (u.pn == 4 || u.pn == 5) { const int cc = (u.pn - 4) * 256 + bj * HALF + wc * 32 + 8 * fq;
                        st16(SBV + vimg_off((row >> 12) * 8 + (cc >> 6), row & 4095, cc & 63), pack8(v0, v1)); }
                    else st16(O + (size_t)row * 2048 + col0 + bj * HALF, pack8(v0, v1)); }
                if (u.pn == 6 || u.pn == 7) { float p = (u.pn == 6) ? part[0] + part[1] : part[0]; p += __shfl_xor(p, 16); p += __shfl_xor(p, 32);
                    if (fq == 0) ((u.pn == 6) ? ssq_cq : ssq_ckv)[(size_t)row * 4 + wc] = p;
                    if (u.pn == 7 && wc == 0) { float p1 = part[1]; p1 += __shfl_xor(p1, 16); p1 += __shfl_xor(p1, 32); if (fq == 0) ssq_kr[row] = p1; } }
            }
    }
};
struct EpiUp {
    static constexpr bool PERM = true, AFTER_DRAIN = false, SSQ_LDS = true, SPLIT = false;
    static constexpr int S0 = 0, S1 = 16;
    __device__ __forceinline__ const float* ssq_src(const Unit& u) const { return u.pn < 3 ? ssq_cq : ssq_ckv; }
    bf16_t* Q; bf16_t* KM; bf16_t* V; const float* ssq_cq; const float* ssq_ckv; const float* ssq_kr; const bf16_t* PROJ0; const float* RT; const float* kn;
    __device__ __forceinline__ void init_lds(PG8_LAS unsigned char*, int) const {}
    __device__ __forceinline__ void wait_half0(const Unit& u, int) const { if (u.pn == 3 || u.pn == 4) wait_v<6>(); else wait_v<6 + 8>(); }
    template <int AI>
    __device__ __forceinline__ void half(const f32x4 (&acc)[2][2][4][2], const Unit& u, int wr, int wc, int fr_, int fq_, const PG8_LAS unsigned char* ss) const {
        int fr = fr_, fq = fq_; asm volatile("" : "+v"(fr), "+v"(fq));
        const int row0 = u.pm * BM + wr * 64 + fr;
        if (u.pn == 3 || u.pn == 4) {
          if constexpr (AI == 1) {
            const int head = 4 * (u.pn - 3) + wc;
            float rsv[8]; rs8_lds(ss, wr * 64 + fr, 1.0f / 128.0f, rsv);
            f32x4 gk[2][2];
#pragma unroll
            for (int bj = 0; bj < 2; ++bj) { gk[bj][0] = *(const f32x4*)(kn + 32 * bj + 8 * fq); gk[bj][1] = *(const f32x4*)(kn + 32 * bj + 8 * fq + 4); }
            const f32x4 gr1 = *(const f32x4*)(kn + 64 + 4 * fq), gr2 = *(const f32x4*)(kn + 80 + 4 * fq);
#pragma unroll
            for (int aim = 0; aim < 4; ++aim) { const int ai = aim >> 1;
                float kr[4]; u32x2 k1[4], k2[4]; f32x4 cs[4], sn[4];
#pragma unroll
                for (int m = (aim & 1) * 2; m < (aim & 1) * 2 + 2; ++m) { const int row = row0 + ai * HALF + m * 16;
                    kr[m] = ssq_kr[row];
                    k1[m] = *(const u32x2*)(PROJ0 + (size_t)row * 2048 + 1920 + 4 * fq); k2[m] = *(const u32x2*)(PROJ0 + (size_t)row * 2048 + 1936 + 4 * fq);
                    cs[m] = *(const f32x4*)(RT + (size_t)row * 32 + 4 * fq); sn[m] = *(const f32x4*)(RT + (size_t)row * 32 + 16 + 4 * fq); }
#pragma unroll
                for (int m = (aim & 1) * 2; m < (aim & 1) * 2 + 2; ++m) {
                    const int row = row0 + ai * HALF + m * 16; const float rs = rsv[ai * 4 + m];
                    float ss = (dot4(acc[ai][0][m][0]) + dot4(acc[ai][0][m][1])) + (dot4(acc[ai][1][m][0]) + dot4(acc[ai][1][m][1]));
                    ss += __shfl_xor(ss, 16); ss += __shfl_xor(ss, 32);
                    const float hr = __builtin_amdgcn_rsqf((ss * rs * rs + kr[m]) * (1.0f / 96.0f) + 1e-6f), f = hr * rs;
                    bf16_t* kd = KM + ((size_t)((row >> 12) * 8 + head) * 64 + ((row & 4095) >> 6)) * 6144 + (size_t)(row & 63) * 8;
#pragma unroll
                    for (int bj = 0; bj < 2; ++bj) st16(kd + (size_t)(4 * bj + fq) * 512, pack8(acc[ai][bj][m][0] * (gk[bj][0] * f), acc[ai][bj][m][1] * (gk[bj][1] * f)));
                    const f32x4 g1 = gr1 * hr, g2 = gr2 * hr; const u32x2 a1 = k1[m], a2 = k2[m];
                    const f32x4 r1 = (f32x4){__builtin_bit_cast(float, a1.x << 16), __builtin_bit_cast(float, a1.x & 0xffff0000u), __builtin_bit_cast(float, a1.y << 16), __builtin_bit_cast(float, a1.y & 0xffff0000u)} * g1;
                    const f32x4 r2 = (f32x4){__builtin_bit_cast(float, a2.x << 16), __builtin_bit_cast(float, a2.x & 0xffff0000u), __builtin_bit_cast(float, a2.y << 16), __builtin_bit_cast(float, a2.y & 0xffff0000u)} * g2;
                    const f32x4 o1 = r1 * cs[m] - r2 * sn[m], o2 = r2 * cs[m] + r1 * sn[m];
                    u32x2 w1, w2; w1.x = cvt_pk_bf16(o1[0], o1[1]); w1.y = cvt_pk_bf16(o1[2], o1[3]); w2.x = cvt_pk_bf16(o2[0], o2[1]); w2.y = cvt_pk_bf16(o2[2], o2[3]);
                    st8(kd + (size_t)(8 + (fq >> 1)) * 512 + (fq & 1) * 4, w1); st8(kd + (size_t)(10 + (fq >> 1)) * 512 + (fq & 1) * 4, w2);
                }
            }
          }
        } else {
            constexpr int ai = AI;
            const bool isq = u.pn < 3; const int colt = isq ? u.pn * 256 : (u.pn - 5) * 256;
            const int col0 = colt + wc * 32 + 8 * fq;
            float rsv[4]; rs4_lds(ss, ai * HALF + wr * 64 + fr, isq ? 1.0f / 256.0f : 1.0f / 128.0f, rsv);
#pragma unroll
                for (int m = 0; m < 4; ++m) {
                    const int row = row0 + ai * HALF + m * 16; const float rs = rsv[m];
#pragma unroll
                    for (int bj = 0; bj < 2; ++bj) { const int c = col0 + bj * HALF;
                        st16(isq ? Q + (size_t)row * 768 + c : V + vimg_off((row >> 12) * 8 + (c >> 6), row & 4095, c & 63), pack8(acc[ai][bj][m][0] * rs, acc[ai][bj][m][1] * rs)); }
                }
        }
    }
};
template <bool BASE_BF16, bool FINAL>
struct EpiRes {
    static constexpr bool PERM = false, AFTER_DRAIN = true, SSQ_LDS = false, SPLIT = false;
    static constexpr int S0 = 0, S1 = 0;
    const void* base; float* out; bf16_t* XB; float* ssq;
    __device__ __forceinline__ void fused(const f32x4 (&acc)[2][2][4][2], const Unit& u, int wr, int wc, int fr_, int fq_, PG8_LAS unsigned char* lds, int tid) const {
        int fr = fr_, fq = fq_; asm volatile("" : "+v"(fr), "+v"(fq));
        const int row0 = u.pm * BM + wr * 64 + fr, col0 = u.pn * BM + wc * 32 + 4 * fq;
        PG8_LAS float* P = (PG8_LAS float*)lds;
#pragma unroll
        for (int ai = 0; ai < 2; ++ai) {
            f32x4 b[4][2][2];
#pragma unroll
            for (int m = 0; m < 4; ++m) { const size_t off = (size_t)(row0 + ai * HALF + m * 16) * 1024 + col0;
#pragma unroll
                for (int bj = 0; bj < 2; ++bj)
#pragma unroll
                    for (int n = 0; n < 2; ++n) {
                        if (BASE_BF16) { const u32x2 w = *(const u32x2*)((const bf16_t*)base + off + bj * HALF + n * 16);
                            b[m][bj][n] = (f32x4){__builtin_bit_cast(float, w.x << 16), __builtin_bit_cast(float, w.x & 0xffff0000u), __builtin_bit_cast(float, w.y << 16), __builtin_bit_cast(float, w.y & 0xffff0000u)}; }
                        else b[m][bj][n] = __builtin_nontemporal_load((const f32x4*)((const float*)base + off + bj * HALF + n * 16)); } }
#pragma unroll
            for (int m = 0; m < 4; ++m) { const size_t off = (size_t)(row0 + ai * HALF + m * 16) * 1024 + col0; float p = 0.f;
#pragma unroll
                for (int bj = 0; bj < 2; ++bj)
#pragma unroll
                    for (int n = 0; n < 2; ++n) { const f32x4 x = b[m][bj][n] + acc[ai][bj][m][n];
                        if (FINAL) __builtin_nontemporal_store(x, (f32x4*)(out + off + bj * HALF + n * 16));
                        else { p += dot4(x); u32x2 w; w.x = cvt_pk_bf16(x[0], x[1]); w.y = cvt_pk_bf16(x[2], x[3]); st8(XB + off + bj * HALF + n * 16, w); } }
                if (!FINAL) { p += __shfl_xor(p, 16); p += __shfl_xor(p, 32); if (fq == 0) P[(ai * HALF + wr * 64 + m * 16 + fr) * 4 + wc] = p; } }
        }
        if (!FINAL) {
            asm volatile("s_waitcnt lgkmcnt(0)" ::: "memory"); __builtin_amdgcn_s_barrier(); asm volatile("" ::: "memory");
            if (tid < 256) { const f32x4 q = *(const PG8_LAS f32x4*)(P + tid * 4); ssq[(size_t)(u.pm * BM + tid) * 4 + u.pn] = (q[0] + q[1]) + (q[2] + q[3]); }
        }
    }
};
struct EpiGU {
    static constexpr bool PERM = true, AFTER_DRAIN = false, SSQ_LDS = true, SPLIT = false;
    static constexpr int S0 = SPLIT ? 4 : 0, S1 = SPLIT ? 4 : 8;
    __device__ __forceinline__ const float* ssq_src(const Unit&) const { return ssqx; }
    bf16_t* H; const float* ssqx;
    __device__ __forceinline__ void init_lds(PG8_LAS unsigned char*, int) const {}
    __device__ __forceinline__ void wait_half0(const Unit&, int) const { wait_v<6 + 4>(); }
    template <int ai>
    __device__ __forceinline__ void half(const f32x4 (&acc)[2][2][4][2], const Unit& u, int wr, int wc, int fr_, int fq_, const PG8_LAS unsigned char* ss) const {
        if (ai == 1 && u.half != 0) return;
        int fr = fr_, fq = fq_; asm volatile("" : "+v"(fr), "+v"(fq));
        const int row0 = u.pm * BM + (u.half == 2 ? HALF : 0) + wr * 64 + fr, col0 = u.pn * 128 + wc * 32 + 8 * fq;
        float msv[4];
#pragma unroll
        for (int i = 0; i < 4; ++i) { const f32x4 a = *(const PG8_LAS f32x4*)(ss + (ai * HALF + wr * 64 + fr + i * 16) * 16); msv[i] = ((a[0] + a[1]) + (a[2] + a[3])) * (1.0f / 1024.0f) + 1e-6f; }
#pragma unroll
            for (int m = 0; m < 4; ++m) {
                const int row = row0 + ai * HALF + m * 16; const float ms = msv[m], cneg = -1.4426950408889634f * __builtin_amdgcn_rsqf(ms);
                f32x4 h[2];
#pragma unroll
                for (int n = 0; n < 2; ++n) { const f32x4 g = acc[ai][0][m][n], up = acc[ai][1][m][n]; const f32x4 a = g * cneg;
                    f32x4 t; t[0] = __builtin_amdgcn_exp2f(a[0]); t[1] = __builtin_amdgcn_exp2f(a[1]); t[2] = __builtin_amdgcn_exp2f(a[2]); t[3] = __builtin_amdgcn_exp2f(a[3]);
                    const f32x4 d = t * ms + ms;
                    f32x4 r; r[0] = __builtin_amdgcn_rcpf(d[0]); r[1] = __builtin_amdgcn_rcpf(d[1]); r[2] = __builtin_amdgcn_rcpf(d[2]); r[3] = __builtin_amdgcn_rcpf(d[3]);
                    h[n] = (g * up) * r; }
                __builtin_nontemporal_store(pack8(h[0], h[1]), (u32x4*)(H + (size_t)row * 2816 + col0));
            }
    }
};
struct EpiProj1 {
    static constexpr bool PERM = true, AFTER_DRAIN = false, SSQ_LDS = true, SPLIT = false;
    static constexpr int S0 = 0, S1 = 16;
    __device__ __forceinline__ const float* ssq_src(const Unit&) const { return ssqx; }
    bf16_t* Q; bf16_t* K; bf16_t* V; const float* ssqx; const float* qg; const float* kg; float qscale; const PG8_LAS unsigned char* gl;
    __device__ __forceinline__ void init_lds(PG8_LAS unsigned char* lds, int tid) const { if (tid < 128) ((PG8_LAS float*)(lds + GAIN_LDS_OFF))[tid] = tid < 64 ? qg[tid] * qscale : kg[tid - 64]; }
    __device__ __forceinline__ void wait_half0(const Unit&, int) const { wait_v<6 + 8>(); }
    template <int ai>
    __device__ __forceinline__ void half(const f32x4 (&acc)[2][2][4][2], const Unit& u, int wr, int wc, int fr_, int fq_, const PG8_LAS unsigned char* ss) const {
        int fr = fr_, fq = fq_; asm volatile("" : "+v"(fr), "+v"(fq));
        const int row0 = u.pm * BM + wr * 64 + fr;
        float rsv[4]; rs4_lds(ss, ai * HALF + wr * 64 + fr, 1.0f / 1024.0f, rsv);
        if (u.pn < 8) {
            const bool isq = u.pn < 4; bf16_t* dst = isq ? Q : K;
            const int head = 4 * (u.pn & 3) + wc, colh = head * 64 + 8 * fq;
            f32x4 gv[2][2];
#pragma unroll
            for (int bj = 0; bj < 2; ++bj)
#pragma unroll
                for (int n = 0; n < 2; ++n) gv[bj][n] = *(const PG8_LAS f32x4*)(gl + (isq ? 0 : 256) + (32 * bj + 8 * fq + 4 * n) * 4);
#pragma unroll
                for (int m = 0; m < 4; ++m) {
                    const int row = row0 + ai * HALF + m * 16; const float rs = rsv[m];
                    float ss2 = (dot4(acc[ai][0][m][0]) + dot4(acc[ai][0][m][1])) + (dot4(acc[ai][1][m][0]) + dot4(acc[ai][1][m][1]));
                    ss2 += __shfl_xor(ss2, 16); ss2 += __shfl_xor(ss2, 32);
                    const float f = rs * __builtin_amdgcn_rsqf(ss2 * (rs * rs) * (1.0f / 64.0f) + 1e-6f);
                    const size_t kimg = ((size_t)((row >> 12) * 16 + head) * 64 + ((row & 4095) >> 6)) * 4096 + (size_t)(row & 63) * 8;
#pragma unroll
                    for (int bj = 0; bj < 2; ++bj) st16(isq ? dst + (size_t)row * 1024 + colh + 32 * bj : dst + kimg + (size_t)(4 * bj + fq) * 512, pack8(acc[ai][bj][m][0] * (gv[bj][0] * f), acc[ai][bj][m][1] * (gv[bj][1] * f)));
                }
        } else {
            const int col0 = (u.pn - 8) * 256 + wc * 32 + 8 * fq;
#pragma unroll
                for (int m = 0; m < 4; ++m) {
                    const int row = row0 + ai * HALF + m * 16; const float rs = rsv[m];
#pragma unroll
                    for (int bj = 0; bj < 2; ++bj) { const int c = col0 + bj * HALF, hd = c >> 6, d = c & 63;
                        st16(V + vimg_off((row >> 12) * 16 + hd, row & 4095, d), pack8(acc[ai][bj][m][0] * rs, acc[ai][bj][m][1] * rs)); }
                }
        }
    }
};

__device__ __forceinline__ void stage4(const void* b0, const void* b0q, const void* b1, const void* b1q, unsigned v0, unsigned d0, unsigned d1) {
    asm volatile("s_nop 4\n\t"
                 "s_mov_b32 m0, %5\n\ts_nop 0\n\tglobal_load_lds_dwordx4 %0, %1\n\t"
                 "s_mov_b32 m0, %6\n\ts_nop 0\n\tglobal_load_lds_dwordx4 %0, %2\n\t"
                 "s_mov_b32 m0, %7\n\ts_nop 0\n\tglobal_load_lds_dwordx4 %0, %3\n\t"
                 "s_mov_b32 m0, %8\n\ts_nop 0\n\tglobal_load_lds_dwordx4 %0, %4"
                 :: "v"(v0), "s"(b0), "s"(b0q), "s"(b1), "s"(b1q), "s"(d0), "s"(d0 + 8192u), "s"(d1), "s"(d1 + 8192u) : "memory");
}
__device__ __forceinline__ void stage1(const void* b0, unsigned v0, unsigned d0) {
    asm volatile("s_nop 4\n\ts_mov_b32 m0, %2\n\ts_nop 0\n\tglobal_load_lds_dwordx4 %0, %1" :: "v"(v0), "s"(b0), "s"(d0) : "memory");
}
template <class Epi, class Sched, bool ALIGN_EPI>
__device__ __forceinline__ void gemm_phase(PG8_LAS unsigned char* lds, const Gemm g, const Sched& S, const Epi& E) {
    const int tid = threadIdx.x, wid = __builtin_amdgcn_readfirstlane(tid >> 6), lane = tid & 63, wr = wid >> 2, wc = wid & 3, fr = lane & 15, fq = lane >> 4;
    const int K = g.K, nt = K / BK, lda = g.lda;
    unsigned voffA, voffB;
    { int R, C; stage_rc(tid * 16, R, C); const int Rb = Epi::PERM ? ((R & ~31) + perm32(R & 31)) : R;
        voffA = (unsigned)(R * lda + C) * 2u; voffB = (unsigned)(Rb * K + C) * 2u; }
    const size_t qvoffA = (size_t)64 * lda * 2, qvoffB = (size_t)64 * K * 2;
    const size_t kstep = (size_t)(BK * 2);
    const size_t hstepA = (size_t)HALF * lda * 2, hstepB = (size_t)HALF * K * 2;
    const size_t tstepA = 2 * hstepA, tstepB = 2 * hstepB;
    const unsigned ldsw = (unsigned)wid * 1024u, ldsu = (unsigned)(size_t)lds;
    const int aoff = lds_byte(wr * 64 + fr, fq * 8), boff = lds_byte(wc * 32 + fr, fq * 8);
#define PG8_ABASE(u) ((const char*)g.A + ((u).pn >= g.split_pn ? (size_t)g.split_off * 2 : (size_t)0) + (size_t)(u).pm * tstepA + ((u).half == 2 ? hstepA : (size_t)0))
#define PG8_BBASE(u) ((const char*)g.Bt + (size_t)(u).pn * tstepB)
#define PG8_SA(b, h) (((b) * 2 + (h)) * HTB)
#define PG8_SB(b, h) ((4 + (b) * 2 + (h)) * HTB)
#define PG8_STAGE(bufoff, gbase, voff) do { _Pragma("unroll") for (int _i = 0; _i < 2; ++_i) \
        __builtin_amdgcn_global_load_lds((const unsigned*)((const char*)(gbase) + (voff)[_i]), (PG8_LAS unsigned*)(lds + (bufoff) + ldsw + _i * 8192), 16, 0, 0); } while (0)
#define PG8_STAGE2(buf0, base0, buf1, base1, voff) stage4((base0), (base0) + q##voff, (base1), (base1) + q##voff, (voff), ldsu + (buf0) + ldsw, ldsu + (buf1) + ldsw)
#define PG8_LDA(dst, b, h) do { _Pragma("unroll") for (int m = 0; m < 4; ++m) _Pragma("unroll") for (int k = 0; k < 2; ++k) dst[m][k] = *(const PG8_LAS bf16x8*)(lds + PG8_SA(b, h) + aoff + m * 2048 + k * 1024); } while (0)
#define PG8_LDB(dst, b, h) do { _Pragma("unroll") for (int n = 0; n < 2; ++n) _Pragma("unroll") for (int k = 0; k < 2; ++k) dst[n][k] = *(const PG8_LAS bf16x8*)(lds + PG8_SB(b, h) + boff + n * 2048 + k * 1024); } while (0)
#define PG8_MMA(ai, bj, At, Bt, Z) do { _Pragma("unroll") for (int m = 0; m < 4; ++m) _Pragma("unroll") for (int n = 0; n < 2; ++n) { \
        f32x4 c_; if constexpr (Z) c_ = (f32x4){0.f, 0.f, 0.f, 0.f}; else c_ = acc[ai][bj][m][n];     \
        c_ = __builtin_amdgcn_mfma_f32_16x16x32_bf16(Bt[n][0], At[m][0], c_, 0, 0, 0); acc[ai][bj][m][n] = __builtin_amdgcn_mfma_f32_16x16x32_bf16(Bt[n][1], At[m][1], c_, 0, 0, 0); } \
        } while (0)
#define PG8_WAIT_V(n) asm volatile("s_waitcnt vmcnt(" #n ")" ::: "memory")
#define PG8_WAIT_L(n) asm volatile("s_waitcnt lgkmcnt(" #n ")" ::: "memory")
#define PG8_BAR __builtin_amdgcn_s_barrier()
#define PG8_SCHED __builtin_amdgcn_sched_barrier(0)
    Unit cur, nxt; int ui = 0;
    if (!S.next(0, cur)) return;
    if constexpr (!Epi::AFTER_DRAIN) E.init_lds(lds, tid);
    f32x4 acc[2][2][4][2];
    bf16x8 At[4][2], B0[2][2], B1[2][2];
    const char* cA = PG8_ABASE(cur); const char* cB = PG8_BBASE(cur);
    PG8_STAGE2(PG8_SB(0, 0), cB, PG8_SB(0, 1), cB + hstepB, voffB); PG8_STAGE2(PG8_SA(0, 0), cA, PG8_SA(0, 1), cA + hstepA, voffA);
    if (wr == 1) PG8_BAR;
    PG8_WAIT_V(2); PG8_BAR;
    PG8_STAGE2(PG8_SB(1, 0), cB + kstep, PG8_SB(1, 1), cB + hstepB + kstep, voffB);
    PG8_WAIT_V(4); PG8_BAR;
#define PG8_ITER(FA, ZF, t) do { \
            const bool last = ((t) == nt - 2); \
            const char* a1 = cA + (size_t)((t) + 1) * kstep; \
            const char* a2 = last ? nA : cA + (size_t)((t) + 2) * kstep; const char* b2 = last ? nB : cB + (size_t)((t) + 2) * kstep; \
            const char* b3 = b2 + kstep; \
            PG8_LDB(B0, 0, 0); PG8_LDB(B1, 0, 1); PG8_SCHED; PG8_LDA(At, 0, 0); \
            if constexpr (FA) { wait_v<8 + 1 + Epi::S0 + Epi::S1>(); } else { PG8_STAGE2(PG8_SA(1, 0), a1, PG8_SA(1, 1), a1 + hstepA, voffA); PG8_WAIT_V(8); } \
            PG8_WAIT_L(0); PG8_BAR; PG8_MMA(0, 0, At, B0, ZF); PG8_MMA(0, 1, At, B1, ZF); PG8_BAR; PG8_SCHED; \
            PG8_LDA(At, 0, 1); PG8_STAGE2(PG8_SB(0, 0), b2, PG8_SB(0, 1), b2 + hstepB, voffB); \
            if constexpr (FA) { wait_v<6 + 1 + Epi::S1>(); } else PG8_WAIT_V(6); \
            PG8_WAIT_L(0); PG8_BAR; if (cur.half == 0) { PG8_MMA(1, 0, At, B0, ZF); PG8_MMA(1, 1, At, B1, ZF); } PG8_BAR; PG8_SCHED; \
            PG8_LDB(B0, 1, 0); PG8_LDB(B1, 1, 1); PG8_SCHED; PG8_LDA(At, 1, 0); PG8_STAGE2(PG8_SA(0, 0), a2, PG8_SA(0, 1), a2 + hstepA, voffA); \
            if constexpr (FA) { wait_v<8 + 1 + Epi::S1>(); } else PG8_WAIT_V(8); \
            PG8_WAIT_L(0); PG8_BAR; PG8_MMA(0, 0, At, B0, false); PG8_MMA(0, 1, At, B1, false); PG8_BAR; PG8_SCHED; \
            PG8_LDA(At, 1, 1); PG8_STAGE2(PG8_SB(1, 0), b3, PG8_SB(1, 1), b3 + hstepB, voffB); \
            if constexpr (Epi::SPLIT) { \
                  \
                if (last) { E.template half<0>(acc, cur, wr, wc, fr, fq, lds + SSQ_LDS_OFF + (ui & 1) * SSQ_LDS_BYTES); E.wait_half0(cur, wc); } else PG8_WAIT_V(6); \
            } else PG8_WAIT_V(6); \
            PG8_WAIT_L(0); PG8_BAR; if (cur.half == 0) { PG8_MMA(1, 0, At, B0, false); PG8_MMA(1, 1, At, B1, false); } PG8_BAR; PG8_SCHED; \
        } while (0)
#define PG8_SSQ_DMA() do { if constexpr (Epi::SSQ_LDS) {     \
            const char* sb = (const char*)(E.ssq_src(cur) + (size_t)(cur.pm * BM + (cur.half == 2 ? HALF : 0) + wc * 64) * 4); \
            unsigned l16 = threadIdx.x; asm volatile("" : "+v"(l16)); l16 = (l16 & 63u) * 16u;     \
            stage1(sb, l16, ldsu + SSQ_LDS_OFF + (ui & 1) * SSQ_LDS_BYTES + wc * 1024); } } while (0)
    constexpr bool PRE = !Epi::AFTER_DRAIN;
    bool has_next = Epi::AFTER_DRAIN ? false : S.next(1, nxt);
    const char* nA = has_next ? PG8_ABASE(nxt) : cA; const char* nB = has_next ? PG8_BBASE(nxt) : cB;
    PG8_SSQ_DMA();
    PG8_ITER(false, true, 0);
    for (;;) {
        for (int t = 2; t < nt; t += 2) PG8_ITER(false, false, t);
        if constexpr (PRE) { if (has_next) { PG8_STAGE2(PG8_SA(1, 0), nA + kstep, PG8_SA(1, 1), nA + kstep + hstepA, voffA); } }
        if constexpr (ALIGN_EPI) { if (wr == 0) PG8_BAR; }
        if constexpr (!Epi::AFTER_DRAIN) { if constexpr (!Epi::SPLIT) E.template half<0>(acc, cur, wr, wc, fr, fq, lds + SSQ_LDS_OFF + (ui & 1) * SSQ_LDS_BYTES);
                                           E.template half<1>(acc, cur, wr, wc, fr, fq, lds + SSQ_LDS_OFF + (ui & 1) * SSQ_LDS_BYTES); }
        if (!has_next) break;
        cur = nxt; cA = nA; cB = nB; ++ui;
        if constexpr (ALIGN_EPI) { if (wr == 1) PG8_BAR; }
        has_next = Epi::AFTER_DRAIN ? false : S.next(ui + 1, nxt);
        nA = has_next ? PG8_ABASE(nxt) : cA; nB = has_next ? PG8_BBASE(nxt) : cB;
        PG8_SSQ_DMA();
        if constexpr (PRE) PG8_ITER(true, true, 0); else PG8_ITER(false, true, 0);
    }
#undef PG8_ITER
#undef PG8_SSQ_DMA
    PG8_WAIT_V(0);
    if constexpr (!ALIGN_EPI) { if (wr == 0) PG8_BAR; }
    PG8_BAR;
    if constexpr (Epi::AFTER_DRAIN) E.fused(acc, cur, wr, wc, fr, fq, lds, tid);
#undef PG8_ABASE
#undef PG8_BBASE
#undef PG8_SA
#undef PG8_SB
#undef PG8_STAGE
#undef PG8_STAGE2
#undef PG8_LDA
#undef PG8_LDB
#undef PG8_MMA
#undef PG8_WAIT_V
#undef PG8_WAIT_L
#undef PG8_BAR
#undef PG8_SCHED
}
}

constexpr int NWAVES = 8;
constexpr int NB = 4, SEQ = 4096, T = NB * SEQ, D = 1024, FF = 2816;
constexpr float LOG2E = 1.4426950408889634f;
constexpr float C2_MLA = 0.10206207261596575f * LOG2E;
constexpr float C2_64 = 0.125f * LOG2E;
constexpr int NPHASE = 14;
constexpr int N_LAUNCHES = MK_N_LAUNCHES;

constexpr size_t MiB = 1u << 20;
#if defined(PROBE_PHASE)
constexpr size_t WS_CTL = 0, CTL_ZERO_BYTES = 1 * MiB;
#else
constexpr size_t WS_CTL = 0, CTL_ZERO_BYTES = 64 * 1024;
#endif
constexpr size_t WS_W0IN = 1 * MiB, WS_UP0 = 5 * MiB, WS_WO0 = 6 * MiB, WS_GU0 = 8 * MiB, WS_WD0 = 19 * MiB;
constexpr size_t WS_W1IN = 25 * MiB, WS_WO1 = 31 * MiB, WS_GU1 = 33 * MiB, WS_WD1 = 44 * MiB, WS_WF = 50 * MiB;
constexpr size_t WS_SSQX = 51 * MiB, WS_SSQC = 52 * MiB, WS_SSQKV = 52 * MiB + 512 * 1024, WS_LOGF = 53 * MiB, WS_DEC = 54 * MiB;
constexpr size_t WS_XB = 56 * MiB, WS_O = 88 * MiB, WS_R = 120 * MiB, WS_ROPE = 216 * MiB, WS_QAUG = 218 * MiB, WS_KAUG = 226 * MiB, WS_SBK = WS_R + 64 * MiB, WS_SBV = WS_R + 80 * MiB, WS_END = 234 * MiB;
constexpr size_t R_PROJ0 = WS_R, R_KNOPE = WS_R + 64 * MiB, R_H = WS_R, R_Q1 = WS_R, R_K1 = WS_R + 32 * MiB, R_V1 = WS_R + 64 * MiB;
constexpr size_t DO_QM = 0, DO_KM = 24 * MiB, DO_VM = 48 * MiB;
#if defined(PROBE_PHASE)
constexpr int CW_BAR = 4096, CW_Q10 = 32768;
#else
constexpr int CW_BAR = 4096, CW_Q10 = 12288;
#endif
constexpr int CW_LOGF = CW_Q10 + 64;

constexpr int RING_OFF = 0, RING_BYTES = 131072;
constexpr int LDSCTL_OFF = RING_BYTES, MISC_OFF = LDSCTL_OFF + 320;
constexpr int LDS_BYTES = 147456;

#define GAS __attribute__((address_space(1)))
#define LAS __attribute__((address_space(3)))
typedef unsigned short bf16;
typedef unsigned v4u __attribute__((ext_vector_type(4)));
typedef float f32x4 __attribute__((ext_vector_type(4)));
typedef GAS unsigned gu32;
#define RLX_AGENT __ATOMIC_RELAXED, __HIP_MEMORY_SCOPE_AGENT
#define LDS_WAIT() asm volatile("s_waitcnt lgkmcnt(0)" ::: "memory")
__device__ __forceinline__ unsigned f2bf(float f) { unsigned u = __builtin_bit_cast(unsigned, f); return (u + 0x7fffu + ((u >> 16) & 1u)) >> 16; }
__device__ __forceinline__ unsigned pk2(float lo, float hi) { return f2bf(lo) | (f2bf(hi) << 16); }
__device__ __forceinline__ float bflo(unsigned w) { return __builtin_bit_cast(float, w << 16); }
__device__ __forceinline__ float bfhi(unsigned w) { return __builtin_bit_cast(float, w & 0xffff0000u); }


namespace att {
using bf16x8 = __attribute__((ext_vector_type(8))) short;
using s16x4 = __attribute__((ext_vector_type(4))) short;
using f32x16 = __attribute__((ext_vector_type(16))) float;
using u32x4 = __attribute__((ext_vector_type(4))) unsigned;
typedef unsigned short bf16;
constexpr int NW = 8, QBLK = 32, QB = 256, KVBLK = 64, NSLOT = 3, VSLOTB = 8192;
#define SBAR() __builtin_amdgcn_sched_barrier(0)
__device__ __forceinline__ int crow(int r, int hi) { return (r & 3) + 8 * (r >> 2) + 4 * hi; }
template <bool STRICT> __device__ __forceinline__ void cmask(f32x16& p0, f32x16& p1, int jb, int qrel, int hi) {
    const float NEG = -INFINITY; const int kb = 64 * jb + 4 * hi + (STRICT ? 1 : 0);
#pragma unroll
    for (int r = 0; r < 16; ++r) { const int kv = kb + (r & 3) + 8 * (r >> 2); if (kv > qrel) p0[r] = NEG; if (kv + 32 > qrel) p1[r] = NEG; }
}
__device__ __forceinline__ void glds16(const void* sbase, unsigned voff, unsigned lds_dst) { unsigned keep;
    asm volatile("s_nop 4\n\ts_mov_b32 %0, m0\n\ts_mov_b32 m0, %3\n\ts_nop 0\n\tglobal_load_lds_dwordx4 %1, %2\n\ts_mov_b32 m0, %0" : "=&s"(keep) : "v"(voff), "s"(sbase), "s"(lds_dst) : "memory"); }
__device__ __forceinline__ const char* uni_ptr(const void* p) { const unsigned long long v = (unsigned long long)p; const unsigned lo = __builtin_amdgcn_readfirstlane((unsigned)v), hi = __builtin_amdgcn_readfirstlane((unsigned)(v >> 32));
    return (const char*)(((unsigned long long)hi << 32) | lo); }
typedef float f32x2_t __attribute__((ext_vector_type(2))); typedef __bf16 bf16x2_t __attribute__((ext_vector_type(2)));
__device__ __forceinline__ unsigned cvtpk_s(float lo, float hi) { f32x2_t v = {lo, hi}; bf16x2_t b = __builtin_convertvector(v, bf16x2_t); return __builtin_bit_cast(unsigned, b); }
#define WAIT_BAR(N) asm volatile("s_waitcnt vmcnt(" #N ") lgkmcnt(0)\n\ts_barrier" ::: "memory")
typedef __attribute__((address_space(3))) const char* lds_cptr;
typedef short v4i16_t __attribute__((ext_vector_type(4)));
__device__ __forceinline__ void kload2(bf16x8* kf, lds_cptr kp, int j) { kf[2 * j] = *(const __attribute__((address_space(3))) bf16x8*)(kp + j * 2048); kf[2 * j + 1] = *(const __attribute__((address_space(3))) bf16x8*)(kp + j * 2048 + 512); }
__device__ __forceinline__ s16x4 vtr(lds_cptr p) { return __builtin_bit_cast(s16x4, __builtin_amdgcn_ds_read_tr16_b64_v4i16((__attribute__((address_space(3))) v4i16_t*)p)); }
#define MF32(a, b, c) __builtin_amdgcn_mfma_f32_32x32x16_bf16(a, b, c, 0, 0, 0)
__device__ __forceinline__ void pv(f32x16* o, int vb, bf16x8 pa0, bf16x8 pa1, bf16x8 pa2, bf16x8 pa3) {
#pragma unroll
    for (int d0 = 0; d0 < 2; ++d0) { s16x4 lo[4], hi[4];
#pragma unroll
        for (int ks = 0; ks < 4; ++ks) {
            asm volatile("ds_read_b64_tr_b16 %0,%1 offset:%c2" : "=&v"(lo[ks]) : "v"(vb), "i"(d0 * 4096 + ks * 1024) : "memory");
            asm volatile("ds_read_b64_tr_b16 %0,%1 offset:%c2" : "=&v"(hi[ks]) : "v"(vb), "i"(d0 * 4096 + ks * 1024 + 512) : "memory"); }
        asm volatile("s_waitcnt lgkmcnt(0)" ::: "memory"); SBAR();
#define PK(k) (bf16x8){lo[k][0], lo[k][1], lo[k][2], lo[k][3], hi[k][0], hi[k][1], hi[k][2], hi[k][3]}
        o[d0] = MF32(pa0, PK(0), o[d0]); o[d0] = MF32(pa1, PK(1), o[d0]); o[d0] = MF32(pa2, PK(2), o[d0]); o[d0] = MF32(pa3, PK(3), o[d0]);
#undef PK
    }
}

__device__ __forceinline__ void sb_task(const bf16* Qp, const bf16* Kp, const bf16* Vp, bf16* Op, int qs, char* wlds) {
    int tid = threadIdx.x; asm volatile("" : "+v"(tid));
    const int lane = tid & 63, r32 = lane & 31, hi = lane >> 5;
    bf16x8 qr[4];
#pragma unroll
    for (int j = 0; j < 4; ++j) qr[j] = *reinterpret_cast<const bf16x8*>(Qp + (size_t)(qs + r32) * 2048 + 16 * j + 8 * hi);
    f32x16 o[2]; o[0] = f32x16{}; o[1] = f32x16{};
    float Pc = 1.0f;
    const unsigned ldsb = (unsigned)__builtin_amdgcn_readfirstlane((unsigned)(uintptr_t)wlds);
    const int vb = (int)ldsb + ((lane >> 4) & 1) * 32 + (lane & 3) * 8 + (4 * hi + ((lane & 15) >> 2)) * 64;
    const char* vbase = uni_ptr(Vp);
    for (int k0 = qs; k0 >= 0; k0 -= 32) {
        const int tk = k0 >> 6, half = (k0 >> 5) & 1;
        if (k0 == qs || half == 1) {
#pragma unroll
            for (int w = 0; w < 8; ++w) glds16(vbase + (size_t)tk * 8192 + w * 1024, (unsigned)lane * 16u, ldsb + w * 1024);
        }
        bf16x8 kf[4];
#pragma unroll
        for (int j = 0; j < 4; ++j) kf[j] = *reinterpret_cast<const bf16x8*>(Kp + (size_t)tk * 4096 + (size_t)(2 * j + hi) * 512 + (half * 32 + r32) * 8);
        f32x16 C = f32x16{};
#pragma unroll
        for (int j = 0; j < 4; ++j) C = MF32(kf[j], qr[j], C);
        if (k0 == qs) {
#pragma unroll
            for (int r = 0; r < 16; ++r) if (crow(r, hi) >= r32) C[r] = -INFINITY;
        }
        float gp[4];
#pragma unroll
        for (int g = 0; g < 4; ++g) {
            float rr[4], bb[4];
#pragma unroll
            for (int i = 0; i < 4; ++i) { const float e = __builtin_amdgcn_exp2f(fminf(C[4 * g + i], 115.0f)); rr[i] = __builtin_amdgcn_rcpf(1.0f + e); bb[i] = e * rr[i]; }
            const float s2 = rr[3], s1 = rr[3] * rr[2], s0 = s1 * rr[1]; gp[g] = s0 * rr[0];
            C[4 * g + 3] = bb[3]; C[4 * g + 2] = bb[2] * s2; C[4 * g + 1] = bb[1] * s1; C[4 * g] = bb[0] * s0;
        }
        float GP[8];
#pragma unroll
        for (int g = 0; g < 4; ++g) { auto sw = __builtin_amdgcn_permlane32_swap(__float_as_uint(gp[g]), __float_as_uint(gp[g]), false, false); GP[2 * g] = __uint_as_float(sw[0]); GP[2 * g + 1] = __uint_as_float(sw[1]); }
        float GS[8]; float gs = Pc;
#pragma unroll
        for (int G = 7; G >= 0; --G) { GS[G] = gs; gs *= GP[G]; }
        Pc = gs;
        { const unsigned sel = 0u - (unsigned)hi;
#pragma unroll
          for (int g = 0; g < 4; ++g) { const float m0 = __uint_as_float((__float_as_uint(GS[2 * g]) & ~sel) | (__float_as_uint(GS[2 * g + 1]) & sel));
#pragma unroll
              for (int i = 0; i < 4; ++i) C[4 * g + i] *= m0; } }
        const u32x4 pw0 = (u32x4){cvtpk_s(C[0], C[1]), cvtpk_s(C[2], C[3]), cvtpk_s(C[4], C[5]), cvtpk_s(C[6], C[7])};
        const u32x4 pw1 = (u32x4){cvtpk_s(C[8], C[9]), cvtpk_s(C[10], C[11]), cvtpk_s(C[12], C[13]), cvtpk_s(C[14], C[15])};
        asm volatile("s_waitcnt vmcnt(0)" ::: "memory"); SBAR();
        { const int vbh = vb + half * 2048;
#pragma unroll
          for (int d0 = 0; d0 < 2; ++d0) { s16x4 lo[2], hh[2];
#pragma unroll
              for (int ks = 0; ks < 2; ++ks) {
                  asm volatile("ds_read_b64_tr_b16 %0,%1 offset:%c2" : "=&v"(lo[ks]) : "v"(vbh), "i"(d0 * 4096 + ks * 1024) : "memory");
                  asm volatile("ds_read_b64_tr_b16 %0,%1 offset:%c2" : "=&v"(hh[ks]) : "v"(vbh), "i"(d0 * 4096 + ks * 1024 + 512) : "memory"); }
              asm volatile("s_waitcnt lgkmcnt(0)" ::: "memory"); SBAR();
              o[d0] = MF32(__builtin_bit_cast(bf16x8, pw0), ((bf16x8){lo[0][0], lo[0][1], lo[0][2], lo[0][3], hh[0][0], hh[0][1], hh[0][2], hh[0][3]}), o[d0]);
              o[d0] = MF32(__builtin_bit_cast(bf16x8, pw1), ((bf16x8){lo[1][0], lo[1][1], lo[1][2], lo[1][3], hh[1][0], hh[1][1], hh[1][2], hh[1][3]}), o[d0]); } }
        if (__all(Pc < 0x1p-134f)) break;
    }
    asm volatile("s_waitcnt vmcnt(0)" ::: "memory");
#pragma unroll
    for (int r = 0; r < 16; ++r)
#pragma unroll
        for (int d0 = 0; d0 < 2; ++d0) Op[(size_t)(qs + crow(r, hi)) * 1024 + 32 * d0 + r32] = (bf16)f2bf(o[d0][r]);
}
struct AttnArgs { const bf16* Q; const bf16* K; const bf16* V; bf16* O; const bf16* QA; const bf16* KA; int ldq, ldk, ldv, ldo, lda; float mref; const float* RT; const float* qn; };
template <int KS, bool FOX = false> struct Lay { static constexpr int KSLOTB = FOX ? (2 * KS - 1) * 1024 : KS * 2048, LDS_K = 0, LDS_V = NSLOT * KSLOTB, LDS_WS = LDS_V + NSLOT * VSLOTB, LDS_OST = LDS_WS + NW * 256, LDS_BYTES = LDS_OST + NW * 4096; };

template <int KS, bool FOX, bool NOSUB = false>
__device__ __forceinline__ void attn_unit(const AttnArgs& A, int qb, int tbeg, char* shm) {
    typedef Lay<KS, FOX> L;
    constexpr int KSLOTB = L::KSLOTB, LDS_K = L::LDS_K, LDS_V = L::LDS_V, LDS_WS = L::LDS_WS, LDS_OST = L::LDS_OST, NX = FOX ? 1 : 2 * KS - 8;
    int tid = threadIdx.x; asm volatile("" : "+v"(tid));
    const int lane = tid & 63, r32 = lane & 31, hi = lane >> 5; const int wid = __builtin_amdgcn_readfirstlane(tid >> 6);
    const int q0 = qb * QB;
    const unsigned lds0 = (unsigned)(uintptr_t)shm;
    float* wsf = (float*)(shm + LDS_WS) + wid * 64;
    const bool xk = (NX > 0) && (wid < NX);
    constexpr long KTILEB = (FOX ? 8 : 2 * KS) * 1024;
    const char* kbase = uni_ptr(A.K) + (long)tbeg * KTILEB + wid * 1024; const char* kbase2 = FOX ? uni_ptr(A.KA) + (long)tbeg * KVBLK * A.lda * 2 : kbase + 8 * 1024;
    const char* vbase = uni_ptr(A.V) + (long)tbeg * 8192 + wid * 1024;
    const unsigned koff = (unsigned)lane * 16u;
    const unsigned koff2 = FOX ? (unsigned)(lane * A.lda + wid * 8) * 2u : koff;
    const unsigned voff = (unsigned)lane * 16u;
    const long kst = KTILEB, kst2 = FOX ? (long)KVBLK * A.lda * 2 : kst, vst = 8192;
    const unsigned kdst = lds0 + LDS_K + wid * 1024, kdst2 = lds0 + LDS_K + (8 + wid) * 1024, vdst = lds0 + LDS_V + wid * 1024;
#define DMA_K(t, s) do { glds16(kbase + (long)(t) * kst, koff, (unsigned)__builtin_amdgcn_readfirstlane(kdst + (s) * KSLOTB)); \
        if (xk) glds16(kbase2 + (long)(t) * kst2, koff2, (unsigned)__builtin_amdgcn_readfirstlane(kdst2 + (s) * KSLOTB)); } while (0)
#define DMA_V(t, s) glds16(vbase + (long)(t) * vst, voff, (unsigned)__builtin_amdgcn_readfirstlane(vdst + (s) * VSLOTB))
#define WAITB(Na, Nb) do { if (xk) { WAIT_BAR(Nb); } else { WAIT_BAR(Na); } } while (0)
    const int vb0 = (int)(lds0 + LDS_V) + ((lane >> 4) & 1) * 32 + (lane & 3) * 8 + (4 * hi + ((lane & 15) >> 2)) * 64;
    const lds_cptr shm3 = (lds_cptr)shm; const lds_cptr kp0 = shm3 + LDS_K + hi * 1024 + r32 * 16;
    const lds_cptr kpa = shm3 + LDS_K + 8192 + r32 * 16 - (KS - 1) * 2048;
    const lds_cptr vp0 = shm3 + LDS_V + ((lane >> 4) & 1) * 32 + (lane & 3) * 8 + (4 * hi + ((lane & 15) >> 2)) * 64;
    bf16x8 kf[2 * KS];
    const int NT = (q0 + QB) / KVBLK - tbeg;
    DMA_K(0, 0); DMA_V(0, 0); DMA_K(1, 1);
    bf16x8 qr[KS];
    { const bf16* Qw = A.Q + (long)(q0 + wid * QBLK + r32) * A.ldq;
#pragma unroll
      for (int d0 = 0; d0 < (FOX ? KS - 1 : KS); ++d0) qr[d0] = *reinterpret_cast<const bf16x8*>(Qw + d0 * 16 + hi * 8);
      if (FOX) { qr[KS - 1] = *reinterpret_cast<const bf16x8*>(A.QA + (long)(q0 + wid * QBLK + r32) * A.lda); if (hi) qr[KS - 1] = bf16x8{0, 0, 0, 0, 0, 0, 0, 0}; } }
    if constexpr (!FOX && KS == 6) {
        float qf[6][8]; float ss = 0.f;
#pragma unroll
        for (int j = 0; j < 6; ++j) { const u32x4 w = __builtin_bit_cast(u32x4, qr[j]);
            qf[j][0] = __builtin_bit_cast(float, w.x << 16); qf[j][1] = __builtin_bit_cast(float, w.x & 0xffff0000u); qf[j][2] = __builtin_bit_cast(float, w.y << 16); qf[j][3] = __builtin_bit_cast(float, w.y & 0xffff0000u);
            qf[j][4] = __builtin_bit_cast(float, w.z << 16); qf[j][5] = __builtin_bit_cast(float, w.z & 0xffff0000u); qf[j][6] = __builtin_bit_cast(float, w.w << 16); qf[j][7] = __builtin_bit_cast(float, w.w & 0xffff0000u);
#pragma unroll
            for (int e = 0; e < 8; ++e) ss += qf[j][e] * qf[j][e]; }
        { auto rr = __builtin_amdgcn_permlane32_swap(__float_as_uint(ss), __float_as_uint(ss), false, false); ss = __uint_as_float(rr[0]) + __uint_as_float(rr[1]); }
        const float rn = 0.14724445f * __builtin_amdgcn_rsqf(ss * (1.0f / 96.0f) + 1e-6f);
        const float* rt = A.RT + (size_t)(q0 + wid * QBLK + r32) * 32 + 8 * hi;
#pragma unroll
        for (int j = 0; j < 4; ++j)
#pragma unroll
            for (int e = 0; e < 8; ++e) qf[j][e] *= rn * A.qn[16 * j + 8 * hi + e];
#pragma unroll
        for (int e = 0; e < 8; ++e) { const float r1 = qf[4][e] * rn * A.qn[64 + 8 * hi + e], r2 = qf[5][e] * rn * A.qn[80 + 8 * hi + e], c = rt[e], sn = rt[16 + e];
            qf[4][e] = r1 * c - r2 * sn; qf[5][e] = r2 * c + r1 * sn; }
#pragma unroll
        for (int j = 0; j < 6; ++j) { const u32x4 w = (u32x4){cvtpk_s(qf[j][0], qf[j][1]), cvtpk_s(qf[j][2], qf[j][3]), cvtpk_s(qf[j][4], qf[j][5]), cvtpk_s(qf[j][6], qf[j][7])}; qr[j] = __builtin_bit_cast(bf16x8, w); }
    }
    const float mref = (FOX || NOSUB) ? 0.f : A.mref;
    float l_reg = 0.f; f32x16 o[2]; o[0] = f32x16{}; o[1] = f32x16{};
    const f32x16 zz = f32x16{};
    const int qrel = wid * QBLK + r32;
#define CMASK(P0, P1, t) do { int jb_ = (t) - (NT - 4); if (jb_ >= 0) cmask<false>(P0, P1, jb_, qrel, hi); } while (0)
#define EX(v) __builtin_amdgcn_exp2f((v) - mref)
    f32x16 pA0, pA1, pB0, pB1;
    int s_prev = 0, s_cur = 0, s_next = 1;
#define ROT() do { s_prev = s_cur; s_cur = s_next; s_next = (s_next == NSLOT - 1) ? 0 : s_next + 1; } while (0)
    DMA_K(2, 2);
    WAITB(3, 5);
    { const lds_cptr kb = kp0;
#pragma unroll
      for (int d0 = 0; d0 < KS; ++d0) {
          const lds_cptr kq = (FOX && d0 == KS - 1) ? kpa : kb;
          const bf16x8 b0 = *(const __attribute__((address_space(3))) bf16x8*)(kq + d0 * 2048), b1 = *(const __attribute__((address_space(3))) bf16x8*)(kq + d0 * 2048 + 512);
          if (d0 == 0) { pA0 = MF32(b0, qr[0], zz); pA1 = MF32(b1, qr[0], zz); } else { pA0 = MF32(b0, qr[d0], pA0); pA1 = MF32(b1, qr[d0], pA1); } } }
    CMASK(pA0, pA1, 0);
#pragma unroll
    for (int r = 0; r < 16; ++r) { pA0[r] = EX(pA0[r]); pA1[r] = EX(pA1[r]); }
    WAITB(0, 0);
    DMA_K(3, 0); DMA_V(1, 1);
    ROT();
#pragma unroll
    for (int j = 0; j < KS; ++j) kload2(kf, ((FOX && j == KS - 1) ? kpa : kp0) + s_cur * KSLOTB, j);
    WAITB(2, 3);
    s16x4 vlo[8], vhi[8]; u32x4 pw0, pw1, pw2, pw3;
#define PKW(P, B) cvtpk_s(P[B], P[B + 1])
#define PAF(k) __builtin_bit_cast(bf16x8, pw##k)
#define VFR(i) (bf16x8){vlo[i][0], vlo[i][1], vlo[i][2], vlo[i][3], vhi[i][0], vhi[i][1], vhi[i][2], vhi[i][3]}
#define PIN(x) asm volatile("" : "+v"(x))
#define GAPA(MF, A0, A1, A2, A3, W0, W1, PW) do { MF; sacc += A0; sacc += A1; sacc += A2; sacc += A3; PIN(sacc); W0; W1; PIN(PW); SBAR(); } while (0)
#define GAPB(MF, X, B) do { MF; X[B] = EX(X[B]); X[B + 1] = EX(X[B + 1]); X[B + 2] = EX(X[B + 2]); X[B + 3] = EX(X[B + 3]); PIN(X); SBAR(); } while (0)
#define VRD(i) do { vlo[i] = vtr(vp_ + (((i) >> 2) * 4096 + ((i) & 3) * 1024)); vhi[i] = vtr(vp_ + (((i) >> 2) * 4096 + ((i) & 3) * 1024 + 512)); } while (0)
#define KRD(G, j) do { if constexpr (KS > (j)) { if (G) { kload2(kf, ((FOX && (j) == KS - 1) ? kpa : kp0) + s_next * KSLOTB, j); SBAR(); } } } while (0)
#define XQK(C0, C1, j) do { if constexpr (KS > (j)) { C0 = MF32(kf[2 * (j)], qr[j], C0); C1 = MF32(kf[2 * (j) + 1], qr[j], C1); SBAR(); } } while (0)
#define STEP(C0, C1, P0, P1, t, GK, GV, GL) do { SBAR(); \
    const lds_cptr vp_ = vp0 + s_prev * VSLOTB; \
    VRD(0); SBAR(); float sacc = (P0[0] + P0[1]); \
    GAPA(C0 = MF32(kf[0], qr[0], zz), P0[2], P0[3], P0[4], P0[5],     pw0[0] = PKW(P0, 0), pw0[1] = PKW(P0, 2), pw0); \
    VRD(4); SBAR(); GAPA(C1 = MF32(kf[1], qr[0], zz), P0[6], P0[7], P0[8], P0[9],     pw0[2] = PKW(P0, 4), pw0[3] = PKW(P0, 6), pw0); \
    VRD(1); SBAR(); GAPA(C0 = MF32(kf[2], qr[1], C0),   P0[10], P0[11], P0[12], P0[13], pw1[0] = PKW(P0, 8), pw1[1] = PKW(P0, 10), pw1); \
    VRD(5); SBAR(); GAPA(C1 = MF32(kf[3], qr[1], C1),   P0[14], P0[15], P1[0], P1[1],   pw1[2] = PKW(P0, 12), pw1[3] = PKW(P0, 14), pw1); \
    VRD(2); SBAR(); GAPA(C0 = MF32(kf[4], qr[2], C0),   P1[2], P1[3], P1[4], P1[5],     pw2[0] = PKW(P1, 0), pw2[1] = PKW(P1, 2), pw2); \
    VRD(6); SBAR(); GAPA(C1 = MF32(kf[5], qr[2], C1),   P1[6], P1[7], P1[8], P1[9],     pw2[2] = PKW(P1, 4), pw2[3] = PKW(P1, 6), pw2); \
    VRD(3); SBAR(); GAPA(C0 = MF32(kf[6], qr[3], C0),   P1[10], P1[11], P1[12], P1[13], pw3[0] = PKW(P1, 8), pw3[1] = PKW(P1, 10), pw3); \
    VRD(7); SBAR(); GAPA(C1 = MF32(kf[7], qr[3], C1),   P1[14], P1[15], 0.f, 0.f,       pw3[2] = PKW(P1, 12), pw3[3] = PKW(P1, 14), pw3); \
    XQK(C0, C1, 4); XQK(C0, C1, 5); \
    l_reg += sacc; \
    if (GK) { DMA_K((t) + 3, s_cur); } if (GV) { DMA_V((t) + 1, s_next); } \
    CMASK(C0, C1, t); \
    SBAR(); \
    GAPB(o[0] = MF32(PAF(0), VFR(0), o[0]), C0, 0); \
    GAPB(o[1] = MF32(PAF(0), VFR(4), o[1]), C0, 4); \
    KRD(GL, 0); GAPB(o[0] = MF32(PAF(1), VFR(1), o[0]), C0, 8); \
    KRD(GL, 1); GAPB(o[1] = MF32(PAF(1), VFR(5), o[1]), C0, 12); \
    KRD(GL, 2); GAPB(o[0] = MF32(PAF(2), VFR(2), o[0]), C1, 0); \
    KRD(GL, 3); GAPB(o[1] = MF32(PAF(2), VFR(6), o[1]), C1, 4); \
    KRD(GL, 4); GAPB(o[0] = MF32(PAF(3), VFR(3), o[0]), C1, 8); \
    KRD(GL, 5); GAPB(o[1] = MF32(PAF(3), VFR(7), o[1]), C1, 12); \
    } while (0)
    int t = 1;
#undef CMASK
#define CMASK(P0, P1, t) do {} while (0)
    for (; t + 5 < NT; t += 2) {
        STEP(pB0, pB1, pA0, pA1, t, true, true, true);     WAITB(2, 3); ROT();
        STEP(pA0, pA1, pB0, pB1, t + 1, true, true, true); WAITB(2, 3); ROT();
    }
#undef CMASK
#define CMASK(P0, P1, t) do { int jb_ = (t) - (NT - 4); if (jb_ >= 0) cmask<false>(P0, P1, jb_, qrel, hi); } while (0)
#define ENDW(tt) do { if ((tt) + 3 < NT) { WAITB(2, 3); } else if ((tt) + 2 < NT) { WAITB(1, 1); } else { WAITB(0, 0); } } while (0)
    for (; t + 1 < NT; t += 2) {
        STEP(pB0, pB1, pA0, pA1, t, (t + 3 < NT), (t + 1 < NT), (t + 1 < NT));     ENDW(t);     ROT();
        STEP(pA0, pA1, pB0, pB1, t + 1, (t + 4 < NT), (t + 2 < NT), (t + 2 < NT)); ENDW(t + 1); ROT();
    }
    STEP(pB0, pB1, pA0, pA1, NT - 1, false, false, false);
    { float sacc = pB0[0] + pB0[1];
#pragma unroll
      for (int r = 2; r < 16; ++r) sacc += pB0[r];
#pragma unroll
      for (int r = 0; r < 16; ++r) sacc += pB1[r];
      l_reg += sacc;
      pw0 = (u32x4){PKW(pB0, 0), PKW(pB0, 2), PKW(pB0, 4), PKW(pB0, 6)}; pw1 = (u32x4){PKW(pB0, 8), PKW(pB0, 10), PKW(pB0, 12), PKW(pB0, 14)};
      pw2 = (u32x4){PKW(pB1, 0), PKW(pB1, 2), PKW(pB1, 4), PKW(pB1, 6)}; pw3 = (u32x4){PKW(pB1, 8), PKW(pB1, 10), PKW(pB1, 12), PKW(pB1, 14)};
      SBAR(); pv(o, vb0 + s_cur * VSLOTB, PAF(0), PAF(1), PAF(2), PAF(3)); }
#undef PKW
#undef PAF
#undef VFR
#undef PIN
#undef GAPA
#undef GAPB
#undef VRD
#undef KRD
#undef XQK
#undef STEP
#undef ENDW
    { auto rr = __builtin_amdgcn_permlane32_swap(__float_as_uint(l_reg), __float_as_uint(l_reg), false, false); l_reg = __uint_as_float(rr[0]) + __uint_as_float(rr[1]); }
    if (hi == 0) wsf[32 + r32] = l_reg; asm volatile("s_waitcnt lgkmcnt(0)" ::: "memory");
    float rli[16];
#pragma unroll
    for (int r = 0; r < 16; ++r) rli[r] = __builtin_amdgcn_rcpf(wsf[32 + crow(r, hi)]);
    bf16* Ow = A.O + (long)(q0 + wid * QBLK) * A.ldo;
    { bf16* stg = (bf16*)(shm + LDS_OST) + wid * 2048;
#pragma unroll
      for (int r = 0; r < 16; ++r) { const int orow = crow(r, hi);
#pragma unroll
          for (int d0 = 0; d0 < 2; ++d0) stg[orow * 64 + d0 * 32 + r32] = (bf16)f2bf(o[d0][r] * rli[r]); }
      asm volatile("s_waitcnt lgkmcnt(0)" ::: "memory");
#pragma unroll
      for (int i = 0; i < 4; ++i) { const int row = i * 8 + (lane >> 3), ch = lane & 7; const u32x4 v = *(const u32x4*)(stg + row * 64 + ch * 8); pg8::st16(Ow + (long)row * A.ldo + ch * 8, v); } }
    asm volatile("s_waitcnt lgkmcnt(0)\n\ts_barrier" ::: "memory");
#undef DMA_K
#undef DMA_V
#undef WAITB
#undef CMASK
#undef EX
#undef ROT
}
#undef SBAR
#undef WAIT_BAR
}

#define XB_TMO      128
#define XB_XCNT(j)  (256  + 64 * (j))
#define XB_XSUB(j)  (1280 + 64 * (j))
#define XB_XGEN(j)  (2304 + 64 * (j))
#define XB_TOP      3328
#define XB_TOPGEN   3392
#define XCD_BAR_WORDS 3456
#define XB_SPIN_CAP (1u << 18)
__device__ __forceinline__ unsigned xb_ld(unsigned* p)              { return __hip_atomic_load(p, __ATOMIC_RELAXED, __HIP_MEMORY_SCOPE_AGENT); }
__device__ __forceinline__ unsigned xb_add(unsigned* p, unsigned v) { return __hip_atomic_fetch_add(p, v, __ATOMIC_RELAXED, __HIP_MEMORY_SCOPE_AGENT); }
__device__ __forceinline__ unsigned xb_xcc_id() { return (unsigned)__builtin_amdgcn_s_getreg((3 << 11) | 20) & 0xFu; }
#define XB_SPIN(cond, bar) do { unsigned _sp = 0; while (cond) { __builtin_amdgcn_s_sleep(1); \
    if ((++_sp & 255u) == 0u) { if (xb_ld(&(bar)[XB_TMO])) break; if (_sp > XB_SPIN_CAP) { atomicAdd(&(bar)[XB_TMO], 1u); break; } } } } while (0)
struct XcdBarrier { unsigned* bar; unsigned x; volatile LAS unsigned* st; };
__device__ __forceinline__ XcdBarrier xcd_barrier_post(unsigned* bar, volatile LAS unsigned* st) {
    XcdBarrier b; b.bar = bar; b.x = xb_xcc_id(); b.st = st;
    if (threadIdx.x == 0) (void)xb_add(&bar[XB_XCNT(b.x)], 1u);
    return b;
}
__device__ __forceinline__ void xcd_barrier_complete(unsigned* bar, unsigned x, unsigned& nloc, unsigned& nx) {
    const unsigned G = gridDim.x * gridDim.y * gridDim.z;
    unsigned sum, cnt, mine, sp = 0u;
    for (;;) {
        sum = 0u; cnt = 0u; mine = 0u;
#pragma unroll
        for (unsigned j = 0; j < 16; ++j) { const unsigned c = xb_ld(&bar[XB_XCNT(j)]); sum += c; cnt += (c > 0u) ? 1u : 0u; mine = (j == x) ? c : mine; }
        if (sum == G) break;
        __builtin_amdgcn_s_sleep(1);
        if ((++sp & 255u) == 0u) { if (xb_ld(&bar[XB_TMO])) break; if (sp > XB_SPIN_CAP) { atomicAdd(&bar[XB_TMO], 1u); break; } }
    }
    nloc = mine > 0u ? mine : 1u; nx = cnt > 0u ? cnt : 1u;
}
__device__ __forceinline__ void xcd_barrier(const XcdBarrier& b) {
    asm volatile("s_waitcnt vmcnt(0)" ::: "memory");
    __syncthreads();
    if (threadIdx.x == 64) { __builtin_amdgcn_fence(__ATOMIC_ACQUIRE, "agent"); asm volatile("s_waitcnt vmcnt(0)" ::: "memory"); }
    if (threadIdx.x == 0) {
        unsigned* bar = b.bar;
        __builtin_amdgcn_s_waitcnt(0);
        unsigned nloc = b.st[0], nx = b.st[1];
        if (nloc == 0u) { xcd_barrier_complete(bar, b.x, nloc, nx); b.st[0] = nloc; b.st[1] = nx; }
        const unsigned k = b.st[3] + 1u; b.st[3] = k;
        const unsigned old = xb_add(&bar[XB_XSUB(b.x)], 1u);
        if (old + 1u == k * nloc) {
            __builtin_amdgcn_fence(__ATOMIC_RELEASE, "agent");
            asm volatile("s_waitcnt vmcnt(0)" ::: "memory");
            (void)xb_add(&bar[XB_TOP], 1u);
        }
        XB_SPIN(xb_ld(&bar[XB_TOP]) < k * nx, bar);
    }
    __syncthreads();
}

struct Args { const void* in[25]; float* out; unsigned char* ws; int ph_lo, ph_hi, li, pad; };
struct Frame {
    LAS unsigned char* lds; volatile LAS unsigned* MISC; gu32* ctl;
    int tid, lane, wave, vcu, G;
};
__device__ __forceinline__ float wave_sum(float v) {
#pragma unroll
    for (int o = 1; o < 64; o <<= 1) v += __shfl_xor(v, o);
    return v;
}

enum { MAT_W0IN = 0, MAT_UP0, MAT_WO0, MAT_GU0, MAT_WD0, MAT_W1IN, MAT_WO1, MAT_GU1, MAT_WD1, NMAT };
template <bool RSC>
__device__ __forceinline__ void conv_body(const float* src, int ldw, const float* rs8, float csc, bf16* dst, int Kd, int nsub) {
#pragma unroll
    for (int j = 0; j < 4; ++j) {
        if (j < nsub) {
            f32x4 v[8]; f32x4 r0 = {1.f, 1.f, 1.f, 1.f}, r1 = {1.f, 1.f, 1.f, 1.f};
#pragma unroll
            for (int i = 0; i < 8; ++i) v[i] = __builtin_nontemporal_load((const GAS f32x4*)(src + (size_t)(64 * j + i) * ldw));
            if (RSC) { r0 = *(const GAS f32x4*)(rs8 + 64 * j); r1 = *(const GAS f32x4*)(rs8 + 64 * j + 4); }
            const float sc[8] = {r0[0] * csc, r0[1] * csc, r0[2] * csc, r0[3] * csc, r1[0] * csc, r1[1] * csc, r1[2] * csc, r1[3] * csc};
#pragma unroll
            for (int r = 0; r < 4; ++r) { v4u o; o.x = pk2(v[0][r] * sc[0], v[1][r] * sc[1]); o.y = pk2(v[2][r] * sc[2], v[3][r] * sc[3]); o.z = pk2(v[4][r] * sc[4], v[5][r] * sc[5]); o.w = pk2(v[6][r] * sc[6], v[7][r] * sc[7]);
                pg8::st16(dst + (size_t)r * Kd + 64 * j, o); }
        } else {
#pragma unroll
            for (int r = 0; r < 4; ++r) *(GAS v4u*)(dst + (size_t)r * Kd + 64 * j) = (v4u){0u, 0u, 0u, 0u};
        }
    }
}
__device__ __forceinline__ void conv_task(const Args& a, int mat, int it, int lane) {
    const float* const* in = (const float* const*)a.in; unsigned char* ws = a.ws;
    int Kd = 0, Nd = 0; bf16* WT = nullptr;
    switch (mat) {
        case MAT_W0IN: Kd = 1024; Nd = 2048; WT = (bf16*)(ws + WS_W0IN); break;
        case MAT_UP0:  Kd = 256;  Nd = 1792; WT = (bf16*)(ws + WS_UP0); break;
        case MAT_WO0:  Kd = 1024; Nd = 1024; WT = (bf16*)(ws + WS_WO0); break;
        case MAT_GU0:  Kd = 1024; Nd = 5632; WT = (bf16*)(ws + WS_GU0); break;
        case MAT_WD0:  Kd = 2816; Nd = 1024; WT = (bf16*)(ws + WS_WD0); break;
        case MAT_W1IN: Kd = 1024; Nd = 3072; WT = (bf16*)(ws + WS_W1IN); break;
        case MAT_WO1:  Kd = 1024; Nd = 1024; WT = (bf16*)(ws + WS_WO1); break;
        case MAT_GU1:  Kd = 1024; Nd = 5632; WT = (bf16*)(ws + WS_GU1); break;
        default:       Kd = 2816; Nd = 1024; WT = (bf16*)(ws + WS_WD1); break;
    }
    const int nblk = Nd / 32, kb = it / nblk, nb = it % nblk, k0 = 256 * kb, n0 = 32 * nb;
    const float* W = in[3]; const float* rsc = nullptr; int ldw = 0, col0 = -1, Ksrc = 0; float csc = 1.0f;
    switch (mat) {
        case MAT_W0IN: W = in[3]; ldw = 1952; Ksrc = 1024; rsc = in[2];
            if (n0 < 1536) { col0 = 416 + n0; if (n0 < 512) csc = C2_64; } else if (n0 < 1792) col0 = n0 - 1536; else if (n0 < 1920) col0 = 256 + (n0 - 1792); else if (n0 < 1952) col0 = 384 + (n0 - 1920);
            break;
        case MAT_UP0:
            if (n0 < 768) { W = in[5]; ldw = 768; Ksrc = 256; rsc = in[4]; col0 = n0; }
            else { W = in[7]; ldw = 1024; Ksrc = 128; rsc = in[6]; const int n1 = n0 - 768;
                if (n1 < 512) { const int tp = n1 >> 8, r = n1 & 255, bj = r >> 7, wc = (r >> 5) & 3; col0 = (4 * tp + wc) * 128 + 32 * bj; }
                else { const int n2 = n1 - 512; col0 = (n2 >> 6) * 128 + 64 + (n2 & 63); } }
            break;
        case MAT_WO0: W = in[10]; ldw = 1024; Ksrc = 1024; col0 = n0; break;
        case MAT_GU0: { const int pn = n0 >> 8, r = n0 & 255; W = (r >> 7) ? in[13] : in[12]; ldw = 2816; Ksrc = 1024; rsc = in[11]; col0 = pn * 128 + (r & 127); } break;
        case MAT_WD0: W = in[14]; ldw = 1024; Ksrc = 2816; col0 = n0; break;
        case MAT_W1IN: W = in[16]; ldw = 3088; Ksrc = 1024; rsc = in[15];
            if (n0 < 2048) { const int base = (n0 >= 1024) ? 1024 : 0, n1 = n0 & 1023, pn = n1 >> 8, r = n1 & 255, bj = r >> 7, wc = (r >> 5) & 3; col0 = base + 64 * (4 * pn + wc) + 32 * bj; }
            else col0 = n0;
            break;
        case MAT_WO1: W = in[20]; ldw = 1024; Ksrc = 1024; col0 = n0; break;
        case MAT_GU1: { const int pn = n0 >> 8, r = n0 & 255; W = (r >> 7) ? in[23] : in[22]; ldw = 2816; Ksrc = 1024; rsc = in[21]; col0 = pn * 128 + (r & 127); } break;
        default: W = in[24]; ldw = 1024; Ksrc = 2816; col0 = n0; break;
    }
    const int ng = lane & 7, ks = lane >> 3;
    int nsub = (col0 < 0) ? 0 : (Ksrc - k0) / 64; nsub = nsub < 0 ? 0 : (nsub > 4 ? 4 : nsub);
    if (col0 < 0) col0 = 0;
    const float* src = W + (size_t)(k0 + 8 * ks) * ldw + col0 + 4 * ng;
    bf16* dst = WT + (size_t)(n0 + 4 * ng) * Kd + k0 + 8 * ks;
    if (rsc) conv_body<true>(src, ldw, rsc + k0 + 8 * ks, csc, dst, Kd, nsub); else conv_body<false>(src, ldw, nullptr, csc, dst, Kd, nsub);
}
__device__ __forceinline__ void p0_prologue(Frame& F, const Args& a) {
    const int gw = F.vcu * NWAVES + F.wave, NGW = F.G * NWAVES;
    constexpr int cnt[NMAT] = {64 * 4, 56 * 1, 32 * 4, 176 * 4, 32 * 11, 96 * 4, 32 * 4, 176 * 4, 32 * 11};
    constexpr int NITEMS = cnt[0] + cnt[1] + cnt[2] + cnt[3] + cnt[4] + cnt[5] + cnt[6] + cnt[7] + cnt[8];
    for (int it = gw; it < NITEMS; it += NGW) {
        int r = it, mat = 0;
#pragma unroll
        for (int m = 0; m < NMAT - 1; ++m) { if (mat == m && r >= cnt[m]) { r -= cnt[m]; mat = m + 1; } }
        conv_task(a, mat, r, F.lane);
    }
    { const float* W = (const float*)a.in[16]; const float* g = (const float*)a.in[15]; bf16* WF = (bf16*)(a.ws + WS_WF);
      for (int i = (F.vcu * NWAVES + F.wave) * 64 + F.lane; i < 16 * 1024; i += F.G * NWAVES * 64) { const int j = i >> 10, k = i & 1023; WF[i] = (bf16)f2bf(W[(size_t)k * 3088 + 3072 + j] * g[k]); } }
    { const int* pos = (const int*)a.in[1]; float* RT = (float*)(a.ws + WS_ROPE);
      for (int i = (F.vcu * NWAVES + F.wave) * 64 + F.lane; i < T * 16; i += F.G * NWAVES * 64) { const int t = i >> 4, k = i & 15;
          const float ang = (float)pos[t] * powf(10000.0f, -(float)k / 16.0f); RT[(size_t)t * 32 + k] = cosf(ang); RT[(size_t)t * 32 + 16 + k] = sinf(ang); } }
    { const float* x = (const float*)a.in[0]; bf16* XB = (bf16*)(a.ws + WS_XB); float* ssq = (float*)(a.ws + WS_SSQX);
      for (int m = gw; m < T; m += NGW) {
          const GAS f32x4* xr = (const GAS f32x4*)(x + (size_t)m * D) + F.lane; f32x4 v[4]; float s = 0.f;
#pragma unroll
          for (int j = 0; j < 4; ++j) { v[j] = __builtin_nontemporal_load(xr + 64 * j); s += (v[j].x * v[j].x + v[j].y * v[j].y) + (v[j].z * v[j].z + v[j].w * v[j].w); }
          s = wave_sum(s);
          GAS unsigned long long* o8 = (GAS unsigned long long*)(XB + (size_t)m * D) + F.lane;
#pragma unroll
          for (int j = 0; j < 4; ++j) o8[64 * j] = (unsigned long long)pk2(v[j].x, v[j].y) | ((unsigned long long)pk2(v[j].z, v[j].w) << 32);
          if (F.lane < 4) ssq[(size_t)m * 4 + F.lane] = (F.lane == 0) ? s : 0.f;
      } }
}

__device__ __forceinline__ float fox_mref(const float* qg, const float* kg, int lane_) {
    int lane = lane_; asm volatile("" : "+v"(lane));
    float a = fabsf(qg[lane]), b = fabsf(kg[lane]);
#pragma unroll
    for (int o = 1; o < 64; o <<= 1) { a = fmaxf(a, __shfl_xor(a, o)); b = fmaxf(b, __shfl_xor(b, o)); }
    return 64.0f * C2_64 * a * b * 1.02f + 0.25f;
}
__device__ __forceinline__ float mla_mref(const float* qg, const float* kg, int lane_) {
    int lane = lane_; asm volatile("" : "+v"(lane));
    float a = fmaxf(fabsf(qg[lane]), fabsf(qg[64 + (lane & 31)])), b = fmaxf(fabsf(kg[lane]), fabsf(kg[64 + (lane & 31)]));
#pragma unroll
    for (int o = 1; o < 64; o <<= 1) { a = fmaxf(a, __shfl_xor(a, o)); b = fmaxf(b, __shfl_xor(b, o)); }
    return 96.0f * C2_MLA * a * b * 1.02f + 0.25f;
}
__device__ __forceinline__ void split3(float x, unsigned& h, unsigned& m, unsigned& l) {
    h = f2bf(x); const float r1 = x - __builtin_bit_cast(float, h << 16); m = f2bf(r1); const float r2 = r1 - __builtin_bit_cast(float, m << 16); l = f2bf(r2);
}
__global__ void __launch_bounds__(NWAVES * 64, 2) mk_fwd(Args args) {
    extern __shared__ __attribute__((aligned(16))) unsigned char lds[];
    Frame F;
    F.lds = (LAS unsigned char*)lds;
    F.MISC = (volatile LAS unsigned*)(F.lds + MISC_OFF);
    F.tid = threadIdx.x; F.lane = F.tid & 63; F.wave = __builtin_amdgcn_readfirstlane(F.tid >> 6);
    F.G = gridDim.x; { const int bx = blockIdx.x; F.vcu = (F.G % 8 == 0) ? (bx % 8) * (F.G / 8) + bx / 8 : bx; }
    unsigned char* ws = args.ws;
    F.ctl = (gu32*)(ws + WS_CTL);
    for (int u = F.tid; u < (LDS_BYTES - LDSCTL_OFF) / 4; u += NWAVES * 64) ((LAS unsigned*)(F.lds + LDSCTL_OFF))[u] = 0u;
    __syncthreads();
    XcdBarrier bar; bar.bar = (unsigned*)(F.ctl + CW_BAR) + args.li * XCD_BAR_WORDS; bar.x = 0; bar.st = nullptr;
    if (N_LAUNCHES == 1) bar = xcd_barrier_post((unsigned*)(F.ctl + CW_BAR) + args.li * XCD_BAR_WORDS, F.MISC + 8);
#define GRID_BAR() do { if (N_LAUNCHES == 1) xcd_barrier(bar); } while (0)
    const int lo = args.ph_lo, hi = args.ph_hi;
#ifndef PHASE_MASK
#define PHASE_MASK 0xffff
#endif
#define IN(k) (((PHASE_MASK >> (k)) & 1) && lo <= (k) && (k) < hi)
#define BOTH(k) (IN(k) && IN((k) + 1))
    const float* const* in = (const float* const*)args.in;
    bf16* XB = (bf16*)(ws + WS_XB); bf16* OB = (bf16*)(ws + WS_O);
    float* SSQX = (float*)(ws + WS_SSQX); float* SSQC = (float*)(ws + WS_SSQC); float* SSQKV = (float*)(ws + WS_SSQKV); float* SSQKR = (float*)(ws + WS_SSQKV + 256 * 1024);
    bf16* PROJ0 = (bf16*)(ws + R_PROJ0); bf16* KNOPE = (bf16*)(ws + R_KNOPE); bf16* HB = (bf16*)(ws + R_H);
    bf16* Q1 = (bf16*)(ws + R_Q1); bf16* K1 = (bf16*)(ws + R_K1); bf16* V1 = (bf16*)(ws + R_V1);
    bf16* QM = (bf16*)((unsigned char*)args.out + DO_QM); bf16* KM = (bf16*)((unsigned char*)args.out + DO_KM); bf16* VM = (bf16*)((unsigned char*)args.out + DO_VM);
    float* LOGF = (float*)(ws + WS_LOGF); float* CT = (float*)(ws + WS_DEC); bf16* QAUG = (bf16*)(ws + WS_QAUG); bf16* KAUG = (bf16*)(ws + WS_KAUG);

    if (IN(0)) { p0_prologue(F, args); if (BOTH(0)) GRID_BAR(); }
    if (IN(1)) {
        pg8::Gemm g{XB, (const bf16*)(ws + WS_W0IN), T, 2048, 1024, 1024, 1 << 30, 0}; pg8::StaticOrder S; S.init(T, 2048, F.G, (int)blockIdx.x);
        pg8::EpiProj0 E{PROJ0, (bf16*)(ws + WS_SBK), (bf16*)(ws + WS_SBV), SSQX, SSQC, SSQKV, SSQKR};
        pg8::gemm_phase<pg8::EpiProj0, pg8::StaticOrder, true>(F.lds + RING_OFF, g, S, E);
        if (BOTH(1)) GRID_BAR();
    }
    if (IN(2)) {
        pg8::Gemm g{PROJ0 + 1536, (const bf16*)(ws + WS_UP0), T, 1792, 256, 2048, 3, 256}; pg8::StaticOrder S; S.init(T, 1792, F.G, (int)blockIdx.x);
        pg8::EpiUp E{QM, KM, VM, SSQC, SSQKV, SSQKR, PROJ0, (const float*)(ws + WS_ROPE), in[9]};
        pg8::gemm_phase<pg8::EpiUp, pg8::StaticOrder, true>(F.lds + RING_OFF, g, S, E);
        if (BOTH(2)) GRID_BAR();
    }
    if (IN(4)) {
        { const float mref = mla_mref(in[8], in[9], F.lane);
          for (int v = F.vcu; v < 256; v += F.G) {
              const int bh = v >> 3, s8 = v & 7, b = bh >> 3, h = bh & 7; const size_t rb = (size_t)b * SEQ;
              att::AttnArgs A{QM + rb * 768 + h * 96, KM + (size_t)bh * 64 * 6144, VM + (size_t)bh * 64 * 4096, OB + rb * 1024 + h * 64, nullptr, nullptr, 768, 768, 512, 1024, 0, mref, (const float*)(ws + WS_ROPE) + rb * 32, in[8]};
              if (__builtin_amdgcn_readfirstlane((int)(mref <= 64.0f))) {
#pragma unroll 1
                  for (int i = 0; i < 2; ++i) att::attn_unit<6, false, true>(A, i == 0 ? s8 : 15 - s8, 0, (char*)lds + RING_OFF);
              } else {
#pragma unroll 1
                  for (int i = 0; i < 2; ++i) att::attn_unit<6, false, false>(A, i == 0 ? s8 : 15 - s8, 0, (char*)lds + RING_OFF);
              }
          } }
        for (int wt = F.vcu; wt < 512; wt += F.G) {
            const int bh = wt >> 4, b = bh >> 3, h = bh & 7, qs = (wt & 15) * 256 + F.wave * 32; const size_t rb = (size_t)b * SEQ;
            att::sb_task(PROJ0 + rb * 2048 + h * 64, (const bf16*)(ws + WS_SBK) + (size_t)bh * 64 * 4096, (const bf16*)(ws + WS_SBV) + (size_t)bh * 64 * 4096, OB + rb * 1024 + 512 + h * 64, qs, (char*)lds + RING_OFF + F.wave * 8192);
        }
        if (BOTH(4)) GRID_BAR();
    }
    if (IN(5)) {
        pg8::Gemm g{OB, (const bf16*)(ws + WS_WO0), T, 1024, 1024, 1024, 1 << 30, 0}; pg8::StaticOrder S; S.init(T, 1024, F.G, (int)blockIdx.x);
        pg8::EpiRes<true, false> E{XB, nullptr, XB, SSQX};
        pg8::gemm_phase<pg8::EpiRes<true, false>, pg8::StaticOrder, false>(F.lds + RING_OFF, g, S, E);
        if (BOTH(5)) GRID_BAR();
    }
    if (IN(6)) {
        pg8::Gemm g{XB, (const bf16*)(ws + WS_GU0), T, 5632, 1024, 1024, 1 << 30, 0}; pg8::HalfTailOrder S; S.init(T, 5632, F.G, (int)blockIdx.x);
        pg8::EpiGU E{HB, SSQX};
        pg8::gemm_phase<pg8::EpiGU, pg8::HalfTailOrder, true>(F.lds + RING_OFF, g, S, E);
        if (BOTH(6)) GRID_BAR();
    }
    if (IN(7)) {
        pg8::Gemm g{HB, (const bf16*)(ws + WS_WD0), T, 1024, 2816, 2816, 1 << 30, 0}; pg8::StaticOrder S; S.init(T, 1024, F.G, (int)blockIdx.x);
        pg8::EpiRes<true, false> E{XB, nullptr, XB, SSQX};
        pg8::gemm_phase<pg8::EpiRes<true, false>, pg8::StaticOrder, false>(F.lds + RING_OFF, g, S, E);
        if (BOTH(7)) GRID_BAR();
    }
    if (IN(8)) {
        {
          const bf16* WF = (const bf16*)(ws + WS_WF); const float* fb = in[17];
          const int fr = F.lane & 15, fq = F.lane >> 4, kh = F.wave & 1, pr = F.wave >> 1;
          LAS f32x4* xch = (LAS f32x4*)(F.lds + RING_OFF);
          for (int rg0 = F.vcu * 4; rg0 < T / 16; rg0 += F.G * 4) {
              const int rg = rg0 + pr;
              const bf16* ap = XB + (size_t)(rg * 16 + fr) * 1024 + 8 * fq + 512 * kh; const bf16* bp = WF + (size_t)fr * 1024 + 8 * fq + 512 * kh;
              pg8::bf16x8 av[16], bv[16];
#pragma unroll
              for (int kk = 0; kk < 16; ++kk) { av[kk] = *(const pg8::bf16x8*)(ap + 32 * kk); bv[kk] = *(const pg8::bf16x8*)(bp + 32 * kk); }
              pg8::f32x4 c = {0.f, 0.f, 0.f, 0.f};
#pragma unroll
              for (int kk = 0; kk < 16; ++kk) c = __builtin_amdgcn_mfma_f32_16x16x32_bf16(av[kk], bv[kk], c, 0, 0, 0);
              if (kh) xch[pr * 64 + F.lane] = c;
              __syncthreads();
              if (!kh) {
                  c += xch[pr * 64 + F.lane];
                  const int row0 = rg * 16 + 4 * fq, b = row0 / SEQ, s0 = row0 % SEQ; const float bias = fb[fr]; f32x4 lf;
#pragma unroll
                  for (int r = 0; r < 4; ++r) { const float xx = c[r] * pg8::rs4(SSQX, row0 + r, 1.0f / 1024.0f) + bias; lf[r] = fminf(xx, 0.f) - log1pf(expf(-fabsf(xx))); }
                  float* dst = LOGF + ((size_t)(b * 16 + fr)) * SEQ + s0;
                  asm volatile("global_store_dwordx4 %0, %1, off sc1" :: "v"(dst), "v"(lf) : "memory");
              }
              asm volatile("s_waitcnt vmcnt(0)" ::: "memory");
              __syncthreads();
              if (F.tid == 0) __hip_atomic_fetch_add((unsigned*)(F.ctl + CW_LOGF + 16 * ((rg0 * 16) / SEQ)), 4u, __ATOMIC_RELAXED, __HIP_MEMORY_SCOPE_AGENT);
          } }
        pg8::Gemm g{XB, (const bf16*)(ws + WS_W1IN), T, 3072, 1024, 1024, 1 << 30, 0}; pg8::StaticOrder S; S.init(T, 3072, F.G, (int)blockIdx.x);
        pg8::EpiProj1 E{Q1, K1, V1, SSQX, in[18], in[19], C2_64, F.lds + RING_OFF + pg8::GAIN_LDS_OFF};
        pg8::gemm_phase<pg8::EpiProj1, pg8::StaticOrder, true>(F.lds + RING_OFF, g, S, E);
    }
    if (IN(9)) {
        LAS float* wsum = (LAS float*)(F.lds + RING_OFF); const float mref9 = fox_mref(in[18], in[19], F.lane);
        for (int u = F.vcu; u < 256; u += F.G) {
            const int sq = u >> 2, part = u & 3, s0 = part * 1024 + F.tid * 2; const float* lf = LOGF + (size_t)sq * SEQ;
            if (BOTH(8)) {
                if (F.tid == 0) { unsigned* cw = (unsigned*)(F.ctl + CW_LOGF + 16 * (sq >> 4)); unsigned sp = 0;
                    while (__hip_atomic_load(cw, __ATOMIC_RELAXED, __HIP_MEMORY_SCOPE_AGENT) < (unsigned)(SEQ / 16)) { __builtin_amdgcn_s_sleep(1); if (++sp > (1u << 22)) break; }
                    __builtin_amdgcn_fence(__ATOMIC_ACQUIRE, "agent"); }
                __syncthreads();
            }
            float pre = 0.f;
            for (int q = 0; q < part; ++q) { const float2 t2 = *(const float2*)(lf + q * 1024 + F.tid * 2); pre += t2.x + t2.y; }
            pre = wave_sum(pre);
            const float2 me = *(const float2*)(lf + s0); const float v0 = me.x, v1 = me.x + me.y;
            float inc = v1;
#pragma unroll
            for (int o = 1; o < 64; o <<= 1) { const float t = __shfl_up(inc, o); if (F.lane >= o) inc += t; }
            if (F.lane == 63) { wsum[F.wave] = inc; wsum[8 + F.wave] = pre; }
            __syncthreads();
            float basev = inc - v1;
            for (int w = 0; w < 8; ++w) { basev += wsum[8 + w]; if (w < F.wave) basev += wsum[w]; }
#pragma unroll
            for (int i = 0; i < 2; ++i) { const float c2 = (basev + (i ? v1 : v0)) * LOG2E; unsigned a0, a1, a2, b0, b1, b2; split3(c2 - mref9, a0, a1, a2); split3(-c2, b0, b1, b2);
                const size_t ro = ((size_t)sq * SEQ + s0 + i) * 8;
                *(v4u*)(QAUG + ro) = (v4u){a0 | (a1 << 16), a2 | 0x3F800000u, 0x3F803F80u, 0u};
                *(v4u*)(KAUG + ro) = (v4u){0x3F803F80u, 0x3F80u | (b0 << 16), b1 | (b2 << 16), 0u};
                if (((s0 + i) & 63) == 63) CT[sq * 64 + ((s0 + i) >> 6)] = c2; }
            __syncthreads();
        }
        if (BOTH(9)) GRID_BAR();
    }
    if (IN(10)) {
        static_assert(att::Lay<6>::LDS_BYTES <= RING_BYTES && att::Lay<5, true>::LDS_BYTES <= RING_BYTES, "attention LDS");
        const float mref = fox_mref(in[18], in[19], F.lane);
        for (;;) {
            if (F.tid == 0) F.MISC[16] = __hip_atomic_fetch_add((unsigned*)(F.ctl + CW_Q10), 1u, __ATOMIC_RELAXED, __HIP_MEMORY_SCOPE_AGENT);
            __syncthreads();
            const unsigned u = F.MISC[16];
            __syncthreads();
            if (u >= 1024u) break;
            const int qb = 15 - (int)(u >> 6), bh = (int)(u & 63u), b = bh >> 4, h = bh & 15; const size_t rb = (size_t)b * SEQ;
            att::AttnArgs A{Q1 + rb * 1024 + h * 64, K1 + (size_t)bh * 64 * 4096, V1 + (size_t)bh * 64 * 4096, OB + rb * 1024 + h * 64, QAUG + (size_t)bh * SEQ * 8, KAUG + (size_t)bh * SEQ * 8, 1024, 1024, 1024, 1024, 8, mref, nullptr, nullptr};
            const float c2prev = (qb == 0) ? 0.f : CT[bh * 64 + 4 * qb - 1];
            const bool skip = (F.lane < 4 * qb) && (c2prev - CT[bh * 64 + F.lane] < -136.0f);
            const unsigned long long keep = ~__ballot(skip);
            int tb = (int)__builtin_ctzll(keep) & ~1; tb = tb > 4 * qb ? 4 * qb : tb; tb = __builtin_amdgcn_readfirstlane(tb);
            att::attn_unit<5, true>(A, qb, tb, (char*)lds + RING_OFF);
        }
        if (BOTH(10)) GRID_BAR();
    }
    if (IN(11)) {
        pg8::Gemm g{OB, (const bf16*)(ws + WS_WO1), T, 1024, 1024, 1024, 1 << 30, 0}; pg8::StaticOrder S; S.init(T, 1024, F.G, (int)blockIdx.x);
        pg8::EpiRes<true, false> E{XB, nullptr, XB, SSQX};
        pg8::gemm_phase<pg8::EpiRes<true, false>, pg8::StaticOrder, false>(F.lds + RING_OFF, g, S, E);
        if (BOTH(11)) GRID_BAR();
    }
    if (IN(12)) {
        pg8::Gemm g{XB, (const bf16*)(ws + WS_GU1), T, 5632, 1024, 1024, 1 << 30, 0}; pg8::HalfTailOrder S; S.init(T, 5632, F.G, (int)blockIdx.x);
        pg8::EpiGU E{HB, SSQX};
        pg8::gemm_phase<pg8::EpiGU, pg8::HalfTailOrder, true>(F.lds + RING_OFF, g, S, E);
        if (BOTH(12)) GRID_BAR();
    }
    if (IN(13)) {
        pg8::Gemm g{HB, (const bf16*)(ws + WS_WD1), T, 1024, 2816, 2816, 1 << 30, 0}; pg8::StaticOrder S; S.init(T, 1024, F.G, (int)blockIdx.x);
        pg8::EpiRes<true, true> E{XB, args.out, nullptr, nullptr};
        pg8::gemm_phase<pg8::EpiRes<true, true>, pg8::StaticOrder, false>(F.lds + RING_OFF, g, S, E);
    }
#undef IN
#undef BOTH
}

extern "C" void kernel_launch(void* const* d_in, const int* in_sizes, int n_in, void* d_out, int out_size, void* d_ws, size_t ws_size, hipStream_t stream) {
    static int grid = 0;
    if (grid == 0) {
        if (n_in != 25 || in_sizes[0] != T * D || out_size != T * D || ws_size < WS_END) { fprintf(stderr, "kernel_launch: unexpected shapes (n_in %d, in0 %d, out %d, ws %zu)\n", n_in, n_in > 0 ? in_sizes[0] : -1, out_size, ws_size); grid = -1; return; }
        int dev = 0, cus = 0, per_cu = 0;
        if (hipGetDevice(&dev) != hipSuccess || hipDeviceGetAttribute(&cus, hipDeviceAttributeMultiprocessorCount, dev) != hipSuccess) { grid = -1; return; }
        if (hipFuncSetAttribute((const void*)mk_fwd, hipFuncAttributeMaxDynamicSharedMemorySize, LDS_BYTES) != hipSuccess) { fprintf(stderr, "kernel_launch: hipFuncSetAttribute failed\n"); grid = -1; return; }
        if (hipOccupancyMaxActiveBlocksPerMultiprocessor(&per_cu, (const void*)mk_fwd, NWAVES * 64, LDS_BYTES) != hipSuccess || per_cu < 1) { fprintf(stderr, "kernel_launch: occupancy query says %d blocks per CU\n", per_cu); per_cu = 1; }
        (void)hipGetLastError();
        grid = cus;
    }
    if (grid < 0) return;
    if (hipMemsetAsync((char*)d_ws + WS_CTL, 0, CTL_ZERO_BYTES, stream) != hipSuccess) return;
    Args a{};
    for (int i = 0; i < 25; ++i) a.in[i] = d_in[i];
    a.out = (float*)d_out; a.ws = (unsigned char*)d_ws;
#if defined(PROBE_PHASE)
    { int li = 0; a.ph_lo = 0; a.ph_hi = PROBE_PHASE + 1; a.li = li++; hipLaunchKernelGGL(mk_fwd, dim3(grid), dim3(NWAVES * 64), LDS_BYTES, stream, a);
      for (int r = 0; r < PROBE_REPS - 1; ++r) { a.ph_lo = PROBE_PHASE; a.ph_hi = PROBE_PHASE + 1; a.li = li++; hipLaunchKernelGGL(mk_fwd, dim3(grid), dim3(NWAVES * 64), LDS_BYTES, stream, a); }
      a.ph_lo = PROBE_PHASE; a.ph_hi = NPHASE; a.li = li++; hipLaunchKernelGGL(mk_fwd, dim3(grid), dim3(NWAVES * 64), LDS_BYTES, stream, a); }
#else
    if (N_LAUNCHES == 1) { a.ph_lo = 0; a.ph_hi = NPHASE; hipLaunchKernelGGL(mk_fwd, dim3(grid), dim3(NWAVES * 64), LDS_BYTES, stream, a); }
    else for (int p = 0; p < NPHASE; ++p) { a.ph_lo = p; a.ph_hi = p + 1; hipLaunchKernelGGL(mk_fwd, dim3(grid), dim3(NWAVES * 64), LDS_BYTES, stream, a); }
#endif
}
```

```cpp
#include <hip/hip_runtime.h>
#include <cstdio>
#include <cstdint>
#include <cmath>

#ifndef MK_N_LAUNCHES
#define MK_N_LAUNCHES 1
#endif

namespace pg8 {
#define PG8_LAS __attribute__((address_space(3)))
typedef unsigned short bf16_t;
typedef short bf16x8 __attribute__((ext_vector_type(8)));
typedef float f32x4 __attribute__((ext_vector_type(4)));
typedef unsigned u32x4 __attribute__((ext_vector_type(4)));
typedef unsigned u32x2 __attribute__((ext_vector_type(2)));
constexpr int BM = 256, BK = 64, HALF = 128, HTB = HALF * BK * 2, STAGE_BYTES = 8 * HTB, NXCD = 8, WGM = 8;
#ifndef MK_WT
#define MK_WT 0
#endif
__device__ __forceinline__ void st16(void* p, u32x4 v) {
#if MK_WT
    asm volatile("global_store_dwordx4 %0, %1, off sc1\n\ts_nop 1" :: "v"(p), "v"(v) : "memory");
#else
    *(u32x4*)p = v;
#endif
}
__device__ __forceinline__ void st8(void* p, u32x2 v) {
#if MK_WT
    asm volatile("global_store_dwordx2 %0, %1, off sc1\n\ts_nop 1" :: "v"(p), "v"(v) : "memory");
#else
    *(u32x2*)p = v;
#endif
}

__host__ __device__ __forceinline__ int lds_byte(int r, int c) { const int st = (r >> 4) * 2 + (c >> 5), rr = r & 15, cc = c & 31, ob = rr * 64 + cc * 2; return st * 1024 + (ob ^ (((ob >> 9) & 1) << 5)); }
__host__ __device__ __forceinline__ void stage_rc(int b, int& R, int& C) { const int st = b / 1024, sb = b % 1024, swz = sb ^ (((sb >> 9) & 1) << 5); R = (st >> 1) * 16 + swz / 64; C = (st & 1) * 32 + (swz % 64) / 2; }
__host__ __device__ __forceinline__ int perm32(int rho) { const int n = rho >> 4, i = rho & 15; return 8 * (i >> 2) + 4 * n + (i & 3); }

struct Unit { int pm, pn, half; };
struct Gemm { const bf16_t* A; const bf16_t* Bt; int M, N, K, lda, split_pn, split_off; };

struct StaticOrder {
    int nM, nN, nwg, G, c;
    __host__ __device__ void init(int M, int N, int G_, int c_) { nM = M / BM; nN = N / BM; nwg = nM * nN; G = G_; c = c_; }
    __host__ __device__ bool next(int i, Unit& u) const {
        const long L = (long)i * G + c; if (L >= nwg) return false;
        int wgid = (int)L; { const int q = nwg / NXCD, r = nwg % NXCD, xcd = wgid % NXCD, off = wgid / NXCD; wgid = (xcd < r ? xcd * (q + 1) : r * (q + 1) + (xcd - r) * q) + off; }
        const int nig = WGM * nN, gid = wgid / nig, fm = gid * WGM, gsz = (nM - fm) < WGM ? (nM - fm) : WGM;
        u.pm = fm + ((wgid % nig) % gsz); u.pn = (wgid % nig) / gsz; u.half = 0; return true;
    }
};
struct HalfTailOrder : StaticOrder {
    __host__ __device__ bool next(int i, Unit& u) const {
        const int nfull = nwg / G;
        if (nwg - nfull * G != G / 2 || (G % 16) != 0) return StaticOrder::next(i, u);
        if (i < nfull) return StaticOrder::next(i, u);
        if (i > nfull) return false;
        const int k = c / NXCD, cc = (c % NXCD) + NXCD * (k >> 1);
        StaticOrder t = *this; t.c = cc; t.next(nfull, u); u.half = 1 + (k & 1); return true;
    }
};

__device__ __forceinline__ unsigned cvt_pk_bf16(float lo, float hi) { unsigned r; asm volatile("v_cvt_pk_bf16_f32 %0, %1, %2" : "=v"(r) : "v"(lo), "v"(hi)); return r; }
__device__ __forceinline__ float dot4(f32x4 v) { return (v[0] * v[0] + v[1] * v[1]) + (v[2] * v[2] + v[3] * v[3]); }
__device__ __forceinline__ float rs16(const float* ssq, int row, float invD) {
    const f32x4* p = (const f32x4*)(ssq + (size_t)row * 16); const f32x4 a = p[0], b = p[1], c = p[2], d = p[3];
    const float s = (((a[0] + a[1]) + (a[2] + a[3])) + ((b[0] + b[1]) + (b[2] + b[3]))) + (((c[0] + c[1]) + (c[2] + c[3])) + ((d[0] + d[1]) + (d[2] + d[3])));
    return __builtin_amdgcn_rsqf(s * invD + 1e-6f);
}
__device__ __forceinline__ float rs4(const float* ssq, int row, float invD) {
    const f32x4 a = *(const f32x4*)(ssq + (size_t)row * 4); return __builtin_amdgcn_rsqf(((a[0] + a[1]) + (a[2] + a[3])) * invD + 1e-6f);
}
__device__ __forceinline__ void rs8(const float* ssq, int row0, float invD, float (&rs)[8]) {
    f32x4 a[8];
#pragma unroll
    for (int i = 0; i < 8; ++i) a[i] = *(const f32x4*)(ssq + (size_t)(row0 + (i >> 2) * HALF + (i & 3) * 16) * 4);
#pragma unroll
    for (int i = 0; i < 8; ++i) rs[i] = __builtin_amdgcn_rsqf(((a[i][0] + a[i][1]) + (a[i][2] + a[i][3])) * invD + 1e-6f);
}
constexpr int SSQ_LDS_OFF = 131072 + 4096, SSQ_LDS_BYTES = 4096;
__device__ __forceinline__ void rs8_lds(const PG8_LAS unsigned char* ss, int rl0, float invD, float (&rs)[8]) {
    f32x4 a[8];
#pragma unroll
    for (int i = 0; i < 8; ++i) a[i] = *(const PG8_LAS f32x4*)(ss + (rl0 + (i >> 2) * HALF + (i & 3) * 16) * 16);
#pragma unroll
    for (int i = 0; i < 8; ++i) rs[i] = __builtin_amdgcn_rsqf(((a[i][0] + a[i][1]) + (a[i][2] + a[i][3])) * invD + 1e-6f);
}
__device__ __forceinline__ void rs4_lds(const PG8_LAS unsigned char* ss, int rl0, float invD, float (&rs)[4]) {
    f32x4 a[4];
#pragma unroll
    for (int i = 0; i < 4; ++i) a[i] = *(const PG8_LAS f32x4*)(ss + (rl0 + i * 16) * 16);
#pragma unroll
    for (int i = 0; i < 4; ++i) rs[i] = __builtin_amdgcn_rsqf(((a[i][0] + a[i][1]) + (a[i][2] + a[i][3])) * invD + 1e-6f);
}
template <int N> __device__ __forceinline__ void wait_v() { asm volatile("s_waitcnt vmcnt(%0)" :: "n"(N) : "memory"); }
constexpr int GAIN_LDS_OFF = SSQ_LDS_OFF + 2 * SSQ_LDS_BYTES;
__device__ __forceinline__ u32x4 pack8(f32x4 v0, f32x4 v1) { u32x4 w; w.x = cvt_pk_bf16(v0[0], v0[1]); w.y = cvt_pk_bf16(v0[2], v0[3]); w.z = cvt_pk_bf16(v1[0], v1[1]); w.w = cvt_pk_bf16(v1[2], v1[3]); return w; }
__device__ __forceinline__ size_t vimg_off(int bh, int s, int d) { return ((size_t)bh * 64 + (s >> 6)) * 4096 + (size_t)(((d >> 5) * 4 + ((s & 63) >> 4)) * 512 + (s & 15) * 32 + (d & 31)); }

struct EpiProj0 {
    static constexpr bool PERM = true, AFTER_DRAIN = false, SSQ_LDS = true, SPLIT = false;
    static constexpr int S0 = 0, S1 = 16;
    __device__ __forceinline__ const float* ssq_src(const Unit&) const { return ssqx; }
    bf16_t* O; bf16_t* SBK; bf16_t* SBV; const float* ssqx; float* ssq_cq; float* ssq_ckv; float* ssq_kr;
    __device__ __forceinline__ void init_lds(PG8_LAS unsigned char*, int) const {}
    __device__ __forceinline__ void wait_half0(const Unit& u, int wc) const { if (u.pn < 6) wait_v<6 + 8>(); else if (u.pn == 6 || wc != 0) wait_v<6 + 12>(); else wait_v<6 + 16>(); }
    template <int ai>
    __device__ __forceinline__ void half(const f32x4 (&acc)[2][2][4][2], const Unit& u, int wr, int wc, int fr_, int fq_, const PG8_LAS unsigned char* ss) const {
        int fr = fr_, fq = fq_; asm volatile("" : "+v"(fr), "+v"(fq));
        const int row0 = u.pm * BM + wr * 64 + fr, col0 = u.pn * BM + wc * 32 + 8 * fq;
        float rsv[4]; rs4_lds(ss, ai * HALF + wr * 64 + fr, 1.0f / 1024.0f, rsv);
#pragma unroll
            for (int m = 0; m < 4; ++m) {
                const int row = row0 + ai * HALF + m * 16; const float rs = rsv[m];
                float part[2];
#pragma unroll
                for (int bj = 0; bj < 2; ++bj) { const f32x4 v0 = acc[ai][bj][m][0] * rs, v1 = acc[ai][bj][m][1] * rs; part[bj] = dot4(v0) + dot4(v1);
                    if (u.pn == 2 || u.pn == 3) { const int cc = (u.pn - 2) * 256 + bj * HALF + wc * 32 + 8 * fq, hd = cc >> 6, ch = (cc & 63) >> 3;
                        st16(SBK + ((size_t)((row >> 12) * 8 + hd) * 64 + ((row & 4095) >> 6)) * 4096 + (size_t)ch * 512 + (size_t)(row & 63) * 8, pack8(v0, v1)); }
                    else if (u.pn == 4 || u.pn == 5) { const int cc = (u.pn - 4) * 256 + bj * HALF + wc * 32 + 8 * fq;
                        st16(SBV + vimg_off((row >> 12) * 8 + (cc >> 6), row & 4095, cc & 63), pack8(v0, v1)); }
                    else st16(O + (size_t)row * 2048 + col0 + bj * HALF, pack8(v0, v1)); }
                if (u.pn == 6 || u.pn == 7) { float p = (u.pn == 6) ? part[0] + part[1] : part[0]; p += __shfl_xor(p, 16); p += __shfl_xor(p, 32);
                    if (fq == 0) ((u.pn == 6) ? ssq_cq : ssq_ckv)[(size_t)row * 4 + wc] = p;
                    if (u.pn == 7 && wc == 0) { float p1 = part[1]; p1 += __shfl_xor(p1, 16); p1 += __shfl_xor(p1, 32); if (fq == 0) ssq_kr[row] = p1; } }
            }
    }
};
struct EpiUp {
    static constexpr bool PERM = true, AFTER_DRAIN = false, SSQ_LDS = true, SPLIT = false;
    static constexpr int S0 = 0, S1 = 16;
    __device__ __forceinline__ const float* ssq_src(const Unit& u) const { return u.pn < 3 ? ssq_cq : ssq_ckv; }
    bf16_t* Q; bf16_t* KM; bf16_t* V; const float* ssq_cq; const float* ssq_ckv; const float* ssq_kr; const bf16_t* PROJ0; const float* RT; const float* kn;
    __device__ __forceinline__ void init_lds(PG8_LAS unsigned char*, int) const {}
    __device__ __forceinline__ void wait_half0(const Unit& u, int) const { if (u.pn == 3 || u.pn == 4) wait_v<6>(); else wait_v<6 + 8>(); }
    template <int AI>
    __device__ __forceinline__ void half(const f32x4 (&acc)[2][2][4][2], const Unit& u, int wr, int wc, int fr_, int fq_, const PG8_LAS unsigned char* ss) const {
        int fr = fr_, fq = fq_; asm volatile("" : "+v"(fr), "+v"(fq));
        const int row0 = u.pm * BM + wr * 64 + fr;
        if (u.pn == 3 || u.pn == 4) {
          if constexpr (AI == 1) {
            const int head = 4 * (u.pn - 3) + wc;
            float rsv[8]; rs8_lds(ss, wr * 64 + fr, 1.0f / 128.0f, rsv);
            f32x4 gk[2][2];
#pragma unroll
            for (int bj = 0; bj < 2; ++bj) { gk[bj][0] = *(const f32x4*)(kn + 32 * bj + 8 * fq); gk[bj][1] = *(const f32x4*)(kn + 32 * bj + 8 * fq + 4); }
            const f32x4 gr1 = *(const f32x4*)(kn + 64 + 4 * fq), gr2 = *(const f32x4*)(kn + 80 + 4 * fq);
#pragma unroll
            for (int aim = 0; aim < 4; ++aim) { const int ai = aim >> 1;
                float kr[4]; u32x2 k1[4], k2[4]; f32x4 cs[4], sn[4];
#pragma unroll
                for (int m = (aim & 1) * 2; m < (aim & 1) * 2 + 2; ++m) { const int row = row0 + ai * HALF + m * 16;
                    kr[m] = ssq_kr[row];
                    k1[m] = *(const u32x2*)(PROJ0 + (size_t)row * 2048 + 1920 + 4 * fq); k2[m] = *(const u32x2*)(PROJ0 + (size_t)row * 2048 + 1936 + 4 * fq);
                    cs[m] = *(const f32x4*)(RT + (size_t)row * 32 + 4 * fq); sn[m] = *(const f32x4*)(RT + (size_t)row * 32 + 16 + 4 * fq); }
#pragma unroll
                for (int m = (aim & 1) * 2; m < (aim & 1) * 2 + 2; ++m) {
                    const int row = row0 + ai * HALF + m * 16; const float rs = rsv[ai * 4 + m];
                    float ss = (dot4(acc[ai][0][m][0]) + dot4(acc[ai][0][m][1])) + (dot4(acc[ai][1][m][0]) + dot4(acc[ai][1][m][1]));
                    ss += __shfl_xor(ss, 16); ss += __shfl_xor(ss, 32);
                    const float hr = __builtin_amdgcn_rsqf((ss * rs * rs + kr[m]) * (1.0f / 96.0f) + 1e-6f), f = hr * rs;
                    bf16_t* kd = KM + ((size_t)((row >> 12) * 8 + head) * 64 + ((row & 4095) >> 6)) * 6144 + (size_t)(row & 63) * 8;
#pragma unroll
                    for (int bj = 0; bj < 2; ++bj) st16(kd + (size_t)(4 * bj + fq) * 512, pack8(acc[ai][bj][m][0] * (gk[bj][0] * f), acc[ai][bj][m][1] * (gk[bj][1] * f)));
                    const f32x4 g1 = gr1 * hr, g2 = gr2 * hr; const u32x2 a1 = k1[m], a2 = k2[m];
                    const f32x4 r1 = (f32x4){__builtin_bit_cast(float, a1.x << 16), __builtin_bit_cast(float, a1.x & 0xffff0000u), __builtin_bit_cast(float, a1.y << 16), __builtin_bit_cast(float, a1.y & 0xffff0000u)} * g1;
                    const f32x4 r2 = (f32x4){__builtin_bit_cast(float, a2.x << 16), __builtin_bit_cast(float, a2.x & 0xffff0000u), __builtin_bit_cast(float, a2.y << 16), __builtin_bit_cast(float, a2.y & 0xffff0000u)} * g2;
                    const f32x4 o1 = r1 * cs[m] - r2 * sn[m], o2 = r2 * cs[m] + r1 * sn[m];
                    u32x2 w1, w2; w1.x = cvt_pk_bf16(o1[0], o1[1]); w1.y = cvt_pk_bf16(o1[2], o1[3]); w2.x = cvt_pk_bf16(o2[0], o2[1]); w2.y = cvt_pk_bf16(o2[2], o2[3]);
                    st8(kd + (size_t)(8 + (fq >> 1)) * 512 + (fq & 1) * 4, w1); st8(kd + (size_t)(10 + (fq >> 1)) * 512 + (fq & 1) * 4, w2);
                }
            }
          }
        } else {
            constexpr int ai = AI;
            const bool isq = u.pn < 3; const int colt = isq ? u.pn * 256 : (u.pn - 5) * 256;
            const int col0 = colt + wc * 32 + 8 * fq;
            float rsv[4]; rs4_lds(ss, ai * HALF + wr * 64 + fr, isq ? 1.0f / 256.0f : 1.0f / 128.0f, rsv);
#pragma unroll
                for (int m = 0; m < 4; ++m) {
                    const int row = row0 + ai * HALF + m * 16; const float rs = rsv[m];
#pragma unroll
                    for (int bj = 0; bj < 2; ++bj) { const int c = col0 + bj * HALF;
                        st16(isq ? Q + (size_t)row * 768 + c : V + vimg_off((row >> 12) * 8 + (c >> 6), row & 4095, c & 63), pack8(acc[ai][bj][m][0] * rs, acc[ai][bj][m][1] * rs)); }
                }
        }
    }
};
template <bool BASE_BF16, bool FINAL>
struct EpiRes {
    static constexpr bool PERM = false, AFTER_DRAIN = true, SSQ_LDS = false, SPLIT = false;
    static constexpr int S0 = 0, S1 = 0;
    const void* base; float* out; bf16_t* XB; float* ssq;
    __device__ __forceinline__ void fused(const f32x4 (&acc)[2][2][4][2], const Unit& u, int wr, int wc, int fr_, int fq_, PG8_LAS unsigned char* lds, int tid) const {
        int fr = fr_, fq = fq_; asm volatile("" : "+v"(fr), "+v"(fq));
        const int row0 = u.pm * BM + wr * 64 + fr, col0 = u.pn * BM + wc * 32 + 4 * fq;
        PG8_LAS float* P = (PG8_LAS float*)lds;
#pragma unroll
        for (int ai = 0; ai < 2; ++ai) {
            f32x4 b[4][2][2];
#pragma unroll
            for (int m = 0; m < 4; ++m) { const size_t off = (size_t)(row0 + ai * HALF + m * 16) * 1024 + col0;
#pragma unroll
                for (int bj = 0; bj < 2; ++bj)
#pragma unroll
                    for (int n = 0; n < 2; ++n) {
                        if (BASE_BF16) { const u32x2 w = *(const u32x2*)((const bf16_t*)base + off + bj * HALF + n * 16);
                            b[m][bj][n] = (f32x4){__builtin_bit_cast(float, w.x << 16), __builtin_bit_cast(float, w.x & 0xffff0000u), __builtin_bit_cast(float, w.y << 16), __builtin_bit_cast(float, w.y & 0xffff0000u)}; }
                        else b[m][bj][n] = __builtin_nontemporal_load((const f32x4*)((const float*)base + off + bj * HALF + n * 16)); } }
#pragma unroll
            for (int m = 0; m < 4; ++m) { const size_t off = (size_t)(row0 + ai * HALF + m * 16) * 1024 + col0; float p = 0.f;
#pragma unroll
                for (int bj = 0; bj < 2; ++bj)
#pragma unroll
                    for (int n = 0; n < 2; ++n) { const f32x4 x = b[m][bj][n] + acc[ai][bj][m][n];
                        if (FINAL) __builtin_nontemporal_store(x, (f32x4*)(out + off + bj * HALF + n * 16));
                        else { p += dot4(x); u32x2 w; w.x = cvt_pk_bf16(x[0], x[1]); w.y = cvt_pk_bf16(x[2], x[3]); st8(XB + off + bj * HALF + n * 16, w); } }
                if (!FINAL) { p += __shfl_xor(p, 16); p += __shfl_xor(p, 32); if (fq == 0) P[(ai * HALF + wr * 64 + m * 16 + fr) * 4 + wc] = p; } }
        }
        if (!FINAL) {
            asm volatile("s_waitcnt lgkmcnt(0)" ::: "memory"); __builtin_amdgcn_s_barrier(); asm volatile("" ::: "memory");
            if (tid < 256) { const f32x4 q = *(const PG8_LAS f32x4*)(P + tid * 4); ssq[(size_t)(u.pm * BM + tid) * 4 + u.pn] = (q[0] + q[1]) + (q[2] + q[3]); }
        }
    }
};
struct EpiGU {
    static constexpr bool PERM = true, AFTER_DRAIN = false, SSQ_LDS = true, SPLIT = false;
    static constexpr int S0 = SPLIT ? 4 : 0, S1 = SPLIT ? 4 : 8;
    __device__ __forceinline__ const float* ssq_src(const Unit&) const { return ssqx; }
    bf16_t* H; const float* ssqx;
    __device__ __forceinline__ void init_lds(PG8_LAS unsigned char*, int) const {}
    __device__ __forceinline__ void wait_half0(const Unit&, int) const { wait_v<6 + 4>(); }
    template <int ai>
    __device__ __forceinline__ void half(const f32x4 (&acc)[2][2][4][2], const Unit& u, int wr, int wc, int fr_, int fq_, const PG8_LAS unsigned char* ss) const {
        if (ai == 1 && u.half != 0) return;
        int fr = fr_, fq = fq_; asm volatile("" : "+v"(fr), "+v"(fq));
        const int row0 = u.pm * BM + (u.half == 2 ? HALF : 0) + wr * 64 + fr, col0 = u.pn * 128 + wc * 32 + 8 * fq;
        float msv[4];
#pragma unroll
        for (int i = 0; i < 4; ++i) { const f32x4 a = *(const PG8_LAS f32x4*)(ss + (ai * HALF + wr * 64 + fr + i * 16) * 16); msv[i] = ((a[0] + a[1]) + (a[2] + a[3])) * (1.0f / 1024.0f) + 1e-6f; }
#pragma unroll
            for (int m = 0; m < 4; ++m) {
                const int row = row0 + ai * HALF + m * 16; const float ms = msv[m], cneg = -1.4426950408889634f * __builtin_amdgcn_rsqf(ms);
                f32x4 h[2];
#pragma unroll
                for (int n = 0; n < 2; ++n) { const f32x4 g = acc[ai][0][m][n], up = acc[ai][1][m][n]; const f32x4 a = g * cneg;
                    f32x4 t; t[0] = __builtin_amdgcn_exp2f(a[0]); t[1] = __builtin_amdgcn_exp2f(a[1]); t[2] = __builtin_amdgcn_exp2f(a[2]); t[3] = __builtin_amdgcn_exp2f(a[3]);
                    const f32x4 d = t * ms + ms;
                    f32x4 r; r[0] = __builtin_amdgcn_rcpf(d[0]); r[1] = __builtin_amdgcn_rcpf(d[1]); r[2] = __builtin_amdgcn_rcpf(d[2]); r[3] = __builtin_amdgcn_rcpf(d[3]);
                    h[n] = (g * up) * r; }
                __builtin_nontemporal_store(pack8(h[0], h[1]), (u32x4*)(H + (size_t)row * 2816 + col0));
            }
    }
};
struct EpiProj1 {
    static constexpr bool PERM = true, AFTER_DRAIN = false, SSQ_LDS = true, SPLIT = false;
    static constexpr int S0 = 0, S1 = 16;
    __device__ __forceinline__ const float* ssq_src(const Unit&) const { return ssqx; }
    bf16_t* Q; bf16_t* K; bf16_t* V; const float* ssqx; const float* qg; const float* kg; float qscale; const PG8_LAS unsigned char* gl;
    __device__ __forceinline__ void init_lds(PG8_LAS unsigned char* lds, int tid) const { if (tid < 128) ((PG8_LAS float*)(lds + GAIN_LDS_OFF))[tid] = tid < 64 ? qg[tid] * qscale : kg[tid - 64]; }
    __device__ __forceinline__ void wait_half0(const Unit&, int) const { wait_v<6 + 8>(); }
    template <int ai>
    __device__ __forceinline__ void half(const f32x4 (&acc)[2][2][4][2], const Unit& u, int wr, int wc, int fr_, int fq_, const PG8_LAS unsigned char* ss) const {
        int fr = fr_, fq = fq_; asm volatile("" : "+v"(fr), "+v"(fq));
        const int row0 = u.pm * BM + wr * 64 + fr;
        float rsv[4]; rs4_lds(ss, ai * HALF + wr * 64 + fr, 1.0f / 1024.0f, rsv);
        if (u.pn < 8) {
            const bool isq = u.pn < 4; bf16_t* dst = isq ? Q : K;
            const int head = 4 * (u.pn & 3) + wc, colh = head * 64 + 8 * fq;
            f32x4 gv[2][2];
#pragma unroll
            for (int bj = 0; bj < 2; ++bj)
#pragma unroll
                for (int n = 0; n < 2; ++n) gv[bj][n] = *(const PG8_LAS f32x4*)(gl + (isq ? 0 : 256) + (32 * bj + 8 * fq + 4 * n) * 4);
#pragma unroll
                for (int m = 0; m < 4; ++m) {
                    const int row = row0 + ai * HALF + m * 16; const float rs = rsv[m];
                    float ss2 = (dot4(acc[ai][0][m][0]) + dot4(acc[ai][0][m][1])) + (dot4(acc[ai][1][m][0]) + dot4(acc[ai][1][m][1]));
                    ss2 += __shfl_xor(ss2, 16); ss2 += __shfl_xor(ss2, 32);
                    const float f = rs * __builtin_amdgcn_rsqf(ss2 * (rs * rs) * (1.0f / 64.0f) + 1e-6f);
                    const size_t kimg = ((size_t)((row >> 12) * 16 + head) * 64 + ((row & 4095) >> 6)) * 4096 + (size_t)(row & 63) * 8;
#pragma unroll
                    for (int bj = 0; bj < 2; ++bj) st16(isq ? dst + (size_t)row * 1024 + colh + 32 * bj : dst + kimg + (size_t)(4 * bj + fq) * 512, pack8(acc[ai][bj][m][0] * (gv[bj][0] * f), acc[ai][bj][m][1] * (gv[bj][1] * f)));
                }
        } else {
            const int col0 = (u.pn - 8) * 256 + wc * 32 + 8 * fq;
#pragma unroll
                for (int m = 0; m < 4; ++m) {
                    const int row = row0 + ai * HALF + m * 16; const float rs = rsv[m];
#pragma unroll
                    for (int bj = 0; bj < 2; ++bj) { const int c = col0 + bj * HALF, hd = c >> 6, d = c & 63;
                        st16(V + vimg_off((row >> 12) * 16 + hd, row & 4095, d), pack8(acc[ai][bj][m][0] * rs, acc[ai][bj][m][1] * rs)); }
                }
        }
    }
};

__device__ __forceinline__ void stage4(const void* b0, const void* b0q, const void* b1, const void* b1q, unsigned v0, unsigned d0, unsigned d1) {
    asm volatile(""
                 "s_mov_b32 m0, %5\n\ts_nop 0\n\tglobal_load_lds_dwordx4 %0, %1\n\t"
                 "s_mov_b32 m0, %6\n\ts_nop 0\n\tglobal_load_lds_dwordx4 %0, %2\n\t"
                 "s_mov_b32 m0, %7\n\ts_nop 0\n\tglobal_load_lds_dwordx4 %0, %3\n\t"
                 "s_mov_b32 m0, %8\n\ts_nop 0\n\tglobal_load_lds_dwordx4 %0, %4"
                 :: "v"(v0), "s"(b0), "s"(b0q), "s"(b1), "s"(b1q), "s"(d0), "s"(d0 + 8192u), "s"(d1), "s"(d1 + 8192u) : "memory");
}
__device__ __forceinline__ void stage1(const void* b0, unsigned v0, unsigned d0) {
    asm volatile("s_nop 4\n\ts_mov_b32 m0, %2\n\ts_nop 0\n\tglobal_load_lds_dwordx4 %0, %1" :: "v"(v0), "s"(b0), "s"(d0) : "memory");
}
template <class Epi, class Sched, bool ALIGN_EPI>
__device__ __forceinline__ void gemm_phase(PG8_LAS unsigned char* lds, const Gemm g, const Sched& S, const Epi& E) {
    const int tid = threadIdx.x, wid = __builtin_amdgcn_readfirstlane(tid >> 6), lane = tid & 63, wr = wid >> 2, wc = wid & 3, fr = lane & 15, fq = lane >> 4;
    const int K = g.K, nt = K / BK, lda = g.lda;
    unsigned voffA, voffB;
    { int R, C; stage_rc(tid * 16, R, C); const int Rb = Epi::PERM ? ((R & ~31) + perm32(R & 31)) : R;
        voffA = (unsigned)(R * lda + C) * 2u; voffB = (unsigned)(Rb * K + C) * 2u; }
    const size_t qvoffA = (size_t)64 * lda * 2, qvoffB = (size_t)64 * K * 2;
    const size_t kstep = (size_t)(BK * 2);
    const size_t hstepA = (size_t)HALF * lda * 2, hstepB = (size_t)HALF * K * 2;
    const size_t tstepA = 2 * hstepA, tstepB = 2 * hstepB;
    const unsigned ldsw = (unsigned)wid * 1024u, ldsu = (unsigned)(size_t)lds;
    const int aoff = lds_byte(wr * 64 + fr, fq * 8), boff = lds_byte(wc * 32 + fr, fq * 8);
#define PG8_ABASE(u) ((const char*)g.A + ((u).pn >= g.split_pn ? (size_t)g.split_off * 2 : (size_t)0) + (size_t)(u).pm * tstepA + ((u).half == 2 ? hstepA : (size_t)0))
#define PG8_BBASE(u) ((const char*)g.Bt + (size_t)(u).pn * tstepB)
#define PG8_SA(b, h) (((b) * 2 + (h)) * HTB)
#define PG8_SB(b, h) ((4 + (b) * 2 + (h)) * HTB)
#define PG8_STAGE(bufoff, gbase, voff) do { _Pragma("unroll") for (int _i = 0; _i < 2; ++_i) \
        __builtin_amdgcn_global_load_lds((const unsigned*)((const char*)(gbase) + (voff)[_i]), (PG8_LAS unsigned*)(lds + (bufoff) + ldsw + _i * 8192), 16, 0, 0); } while (0)
#define PG8_STAGE2(buf0, base0, buf1, base1, voff) stage4((base0), (base0) + q##voff, (base1), (base1) + q##voff, (voff), ldsu + (buf0) + ldsw, ldsu + (buf1) + ldsw)
#define PG8_LDA(dst, b, h) do { _Pragma("unroll") for (int m = 0; m < 4; ++m) _Pragma("unroll") for (int k = 0; k < 2; ++k) dst[m][k] = *(const PG8_LAS bf16x8*)(lds + PG8_SA(b, h) + aoff + m * 2048 + k * 1024); } while (0)
#define PG8_LDB(dst, b, h) do { _Pragma("unroll") for (int n = 0; n < 2; ++n) _Pragma("unroll") for (int k = 0; k < 2; ++k) dst[n][k] = *(const PG8_LAS bf16x8*)(lds + PG8_SB(b, h) + boff + n * 2048 + k * 1024); } while (0)
#define PG8_MMA(ai, bj, At, Bt, Z) do { __builtin_amdgcn_s_setprio(1); _Pragma("unroll") for (int m = 0; m < 4; ++m) _Pragma("unroll") for (int n = 0; n < 2; ++n) { \
        f32x4 c_; if constexpr (Z) c_ = (f32x4){0.f, 0.f, 0.f, 0.f}; else c_ = acc[ai][bj][m][n];     \
        c_ = __builtin_amdgcn_mfma_f32_16x16x32_bf16(Bt[n][0], At[m][0], c_, 0, 0, 0); acc[ai][bj][m][n] = __builtin_amdgcn_mfma_f32_16x16x32_bf16(Bt[n][1], At[m][1], c_, 0, 0, 0); } \
        __builtin_amdgcn_s_setprio(0); } while (0)
#define PG8_WAIT_V(n) asm volatile("s_waitcnt vmcnt(" #n ")" ::: "memory")
#define PG8_WAIT_L(n) asm volatile("s_waitcnt lgkmcnt(" #n ")" ::: "memory")
#define PG8_BAR __builtin_amdgcn_s_barrier()
#define PG8_SCHED __builtin_amdgcn_sched_barrier(0)
    Unit cur, nxt; int ui = 0;
    if (!S.next(0, cur)) return;
    if constexpr (!Epi::AFTER_DRAIN) E.init_lds(lds, tid);
    f32x4 acc[2][2][4][2];
    bf16x8 At[4][2], B0[2][2], B1[2][2];
    const char* cA = PG8_ABASE(cur); const char* cB = PG8_BBASE(cur);
    PG8_STAGE2(PG8_SB(0, 0), cB, PG8_SB(0, 1), cB + hstepB, voffB); PG8_STAGE2(PG8_SA(0, 0), cA, PG8_SA(0, 1), cA + hstepA, voffA);
    if (wr == 1) PG8_BAR;
    PG8_WAIT_V(2); PG8_BAR;
    PG8_STAGE2(PG8_SB(1, 0), cB + kstep, PG8_SB(1, 1), cB + hstepB + kstep, voffB);
    PG8_WAIT_V(4); PG8_BAR;
#define PG8_ITER(FA, ZF, t) do { \
            const bool last = ((t) == nt - 2); \
            const char* a1 = cA + (size_t)((t) + 1) * kstep; \
            const char* a2 = last ? nA : cA + (size_t)((t) + 2) * kstep; const char* b2 = last ? nB : cB + (size_t)((t) + 2) * kstep; \
            const char* b3 = b2 + kstep; \
            PG8_LDB(B0, 0, 0); PG8_LDB(B1, 0, 1); PG8_SCHED; PG8_LDA(At, 0, 0); \
            if constexpr (FA) { wait_v<8 + 1 + Epi::S0 + Epi::S1>(); } else { PG8_STAGE2(PG8_SA(1, 0), a1, PG8_SA(1, 1), a1 + hstepA, voffA); PG8_WAIT_V(8); } \
            PG8_WAIT_L(0); PG8_BAR; PG8_MMA(0, 0, At, B0, ZF); PG8_MMA(0, 1, At, B1, ZF); PG8_BAR; PG8_SCHED; \
            PG8_LDA(At, 0, 1); PG8_STAGE2(PG8_SB(0, 0), b2, PG8_SB(0, 1), b2 + hstepB, voffB); \
            if constexpr (FA) { wait_v<6 + 1 + Epi::S1>(); } else PG8_WAIT_V(6); \
            PG8_WAIT_L(0); PG8_BAR; if (cur.half == 0) { PG8_MMA(1, 0, At, B0, ZF); PG8_MMA(1, 1, At, B1, ZF); } PG8_BAR; PG8_SCHED; \
            PG8_LDB(B0, 1, 0); PG8_LDB(B1, 1, 1); PG8_SCHED; PG8_LDA(At, 1, 0); PG8_STAGE2(PG8_SA(0, 0), a2, PG8_SA(0, 1), a2 + hstepA, voffA); \
            if constexpr (FA) { wait_v<8 + 1 + Epi::S1>(); } else PG8_WAIT_V(8); \
            PG8_WAIT_L(0); PG8_BAR; PG8_MMA(0, 0, At, B0, false); PG8_MMA(0, 1, At, B1, false); PG8_BAR; PG8_SCHED; \
            PG8_LDA(At, 1, 1); PG8_STAGE2(PG8_SB(1, 0), b3, PG8_SB(1, 1), b3 + hstepB, voffB); \
            if constexpr (Epi::SPLIT) { \
                  \
                if (last) { E.template half<0>(acc, cur, wr, wc, fr, fq, lds + SSQ_LDS_OFF + (ui & 1) * SSQ_LDS_BYTES); E.wait_half0(cur, wc); } else PG8_WAIT_V(6); \
            } else PG8_WAIT_V(6); \
            PG8_WAIT_L(0); PG8_BAR; if (cur.half == 0) { PG8_MMA(1, 0, At, B0, false); PG8_MMA(1, 1, At, B1, false); } PG8_BAR; PG8_SCHED; \
        } while (0)
#define PG8_SSQ_DMA() do { if constexpr (Epi::SSQ_LDS) {     \
            const char* sb = (const char*)(E.ssq_src(cur) + (size_t)(cur.pm * BM + (cur.half == 2 ? HALF : 0) + wc * 64) * 4); \
            unsigned l16 = threadIdx.x; asm volatile("" : "+v"(l16)); l16 = (l16 & 63u) * 16u;     \
            stage1(sb, l16, ldsu + SSQ_LDS_OFF + (ui & 1) * SSQ_LDS_BYTES + wc * 1024); } } while (0)
    constexpr bool PRE = !Epi::AFTER_DRAIN;
    bool has_next = Epi::AFTER_DRAIN ? false : S.next(1, nxt);
    const char* nA = has_next ? PG8_ABASE(nxt) : cA; const char* nB = has_next ? PG8_BBASE(nxt) : cB;
    PG8_SSQ_DMA();
    PG8_ITER(false, true, 0);
    for (;;) {
        for (int t = 2; t < nt; t += 2) PG8_ITER(false, false, t);
        if constexpr (PRE) { if (has_next) { PG8_STAGE2(PG8_SA(1, 0), nA + kstep, PG8_SA(1, 1), nA + kstep + hstepA, voffA); } }
        if constexpr (ALIGN_EPI) { if (wr == 0) PG8_BAR; }
        if constexpr (!Epi::AFTER_DRAIN) { if constexpr (!Epi::SPLIT) E.template half<0>(acc, cur, wr, wc, fr, fq, lds + SSQ_LDS_OFF + (ui & 1) * SSQ_LDS_BYTES);
                                           E.template half<1>(acc, cur, wr, wc, fr, fq, lds + SSQ_LDS_OFF + (ui & 1) * SSQ_LDS_BYTES); }
        if (!has_next) break;
        cur = nxt; cA = nA; cB = nB; ++ui;
        if constexpr (ALIGN_EPI) { if (wr == 1) PG8_BAR; }
        has_next = Epi::AFTER_DRAIN ? false : S.next(ui + 1, nxt);
        nA = has_next ? PG8_ABASE(nxt) : cA; nB = has_next ? PG8_BBASE(nxt) : cB;
        PG8_SSQ_DMA();
        if constexpr (PRE) PG8_ITER(true, true, 0); else PG8_ITER(false, true, 0);
    }
#undef PG8_ITER
#undef PG8_SSQ_DMA
    PG8_WAIT_V(0);
    if constexpr (!ALIGN_EPI) { if (wr == 0) PG8_BAR; }
    PG8_BAR;
    if constexpr (Epi::AFTER_DRAIN) E.fused(acc, cur, wr, wc, fr, fq, lds, tid);
#undef PG8_ABASE
#undef PG8_BBASE
#undef PG8_SA
#undef PG8_SB
#undef PG8_STAGE
#undef PG8_STAGE2
#undef PG8_LDA
#undef PG8_LDB
#undef PG8_MMA
#undef PG8_WAIT_V
#undef PG8_WAIT_L
#undef PG8_BAR
#undef PG8_SCHED
}
}

constexpr int NWAVES = 8;
constexpr int NB = 4, SEQ = 4096, T = NB * SEQ, D = 1024, FF = 2816;
constexpr float LOG2E = 1.4426950408889634f;
constexpr float C2_MLA = 0.10206207261596575f * LOG2E;
constexpr float C2_64 = 0.125f * LOG2E;
constexpr int NPHASE = 14;
constexpr int N_LAUNCHES = MK_N_LAUNCHES;

constexpr size_t MiB = 1u << 20;
#if defined(PROBE_PHASE)
constexpr size_t WS_CTL = 0, CTL_ZERO_BYTES = 1 * MiB;
#else
constexpr size_t WS_CTL = 0, CTL_ZERO_BYTES = 64 * 1024;
#endif
constexpr size_t WS_W0IN = 1 * MiB, WS_UP0 = 5 * MiB, WS_WO0 = 6 * MiB, WS_GU0 = 8 * MiB, WS_WD0 = 19 * MiB;
constexpr size_t WS_W1IN = 25 * MiB, WS_WO1 = 31 * MiB, WS_GU1 = 33 * MiB, WS_WD1 = 44 * MiB, WS_WF = 50 * MiB;
constexpr size_t WS_SSQX = 51 * MiB, WS_SSQC = 52 * MiB, WS_SSQKV = 52 * MiB + 512 * 1024, WS_LOGF = 53 * MiB, WS_DEC = 54 * MiB;
constexpr size_t WS_XB = 56 * MiB, WS_O = 88 * MiB, WS_R = 120 * MiB, WS_ROPE = 216 * MiB, WS_QAUG = 218 * MiB, WS_KAUG = 226 * MiB, WS_SBK = WS_R + 64 * MiB, WS_SBV = WS_R + 80 * MiB, WS_END = 234 * MiB;
constexpr size_t R_PROJ0 = WS_R, R_KNOPE = WS_R + 64 * MiB, R_H = WS_R, R_Q1 = WS_R, R_K1 = WS_R + 32 * MiB, R_V1 = WS_R + 64 * MiB;
constexpr size_t DO_QM = 0, DO_KM = 24 * MiB, DO_VM = 48 * MiB;
#if defined(PROBE_PHASE)
constexpr int CW_BAR = 4096, CW_Q10 = 32768;
#else
constexpr int CW_BAR = 4096, CW_Q10 = 12288;
#endif
constexpr int CW_LOGF = CW_Q10 + 64;

constexpr int RING_OFF = 0, RING_BYTES = 131072;
constexpr int LDSCTL_OFF = RING_BYTES, MISC_OFF = LDSCTL_OFF + 320;
constexpr int LDS_BYTES = 147456;

#define GAS __attribute__((address_space(1)))
#define LAS __attribute__((address_space(3)))
typedef unsigned short bf16;
typedef unsigned v4u __attribute__((ext_vector_type(4)));
typedef float f32x4 __attribute__((ext_vector_type(4)));
typedef GAS unsigned gu32;
#define RLX_AGENT __ATOMIC_RELAXED, __HIP_MEMORY_SCOPE_AGENT
#define LDS_WAIT() asm volatile("s_waitcnt lgkmcnt(0)" ::: "memory")
__device__ __forceinline__ unsigned f2bf(float f) { unsigned u = __builtin_bit_cast(unsigned, f); return (u + 0x7fffu + ((u >> 16) & 1u)) >> 16; }
__device__ __forceinline__ unsigned pk2(float lo, float hi) { return f2bf(lo) | (f2bf(hi) << 16); }
__device__ __forceinline__ float bflo(unsigned w) { return __builtin_bit_cast(float, w << 16); }
__device__ __forceinline__ float bfhi(unsigned w) { return __builtin_bit_cast(float, w & 0xffff0000u); }


namespace att {
using bf16x8 = __attribute__((ext_vector_type(8))) short;
using s16x4 = __attribute__((ext_vector_type(4))) short;
using f32x16 = __attribute__((ext_vector_type(16))) float;
using u32x4 = __attribute__((ext_vector_type(4))) unsigned;
typedef unsigned short bf16;
constexpr int NW = 8, QBLK = 32, QB = 256, KVBLK = 64, NSLOT = 3, VSLOTB = 8192;
#define SBAR() __builtin_amdgcn_sched_barrier(0)
__device__ __forceinline__ int crow(int r, int hi) { return (r & 3) + 8 * (r >> 2) + 4 * hi; }
template <bool STRICT> __device__ __forceinline__ void cmask(f32x16& p0, f32x16& p1, int jb, int qrel, int hi) {
    const float NEG = -INFINITY; const int kb = 64 * jb + 4 * hi + (STRICT ? 1 : 0);
#pragma unroll
    for (int r = 0; r < 16; ++r) { const int kv = kb + (r & 3) + 8 * (r >> 2); if (kv > qrel) p0[r] = NEG; if (kv + 32 > qrel) p1[r] = NEG; }
}
__device__ __forceinline__ void glds16(const void* sbase, unsigned voff, unsigned lds_dst) { unsigned keep;
    asm volatile("s_nop 4\n\ts_mov_b32 %0, m0\n\ts_mov_b32 m0, %3\n\ts_nop 0\n\tglobal_load_lds_dwordx4 %1, %2\n\ts_mov_b32 m0, %0" : "=&s"(keep) : "v"(voff), "s"(sbase), "s"(lds_dst) : "memory"); }
__device__ __forceinline__ const char* uni_ptr(const void* p) { const unsigned long long v = (unsigned long long)p; const unsigned lo = __builtin_amdgcn_readfirstlane((unsigned)v), hi = __builtin_amdgcn_readfirstlane((unsigned)(v >> 32));
    return (const char*)(((unsigned long long)hi << 32) | lo); }
typedef float f32x2_t __attribute__((ext_vector_type(2))); typedef __bf16 bf16x2_t __attribute__((ext_vector_type(2)));
__device__ __forceinline__ unsigned cvtpk_s(float lo, float hi) { f32x2_t v = {lo, hi}; bf16x2_t b = __builtin_convertvector(v, bf16x2_t); return __builtin_bit_cast(unsigned, b); }
#define WAIT_BAR(N) asm volatile("s_waitcnt vmcnt(" #N ") lgkmcnt(0)\n\ts_barrier" ::: "memory")
typedef __attribute__((address_space(3))) const char* lds_cptr;
typedef short v4i16_t __attribute__((ext_vector_type(4)));
__device__ __forceinline__ void kload2(bf16x8* kf, lds_cptr kp, int j) { kf[2 * j] = *(const __attribute__((address_space(3))) bf16x8*)(kp + j * 2048); kf[2 * j + 1] = *(const __attribute__((address_space(3))) bf16x8*)(kp + j * 2048 + 512); }
__device__ __forceinline__ s16x4 vtr(lds_cptr p) { return __builtin_bit_cast(s16x4, __builtin_amdgcn_ds_read_tr16_b64_v4i16((__attribute__((address_space(3))) v4i16_t*)p)); }
#define MF32(a, b, c) __builtin_amdgcn_mfma_f32_32x32x16_bf16(a, b, c, 0, 0, 0)
__device__ __forceinline__ void pv(f32x16* o, int vb, bf16x8 pa0, bf16x8 pa1, bf16x8 pa2, bf16x8 pa3) {
#pragma unroll
    for (int d0 = 0; d0 < 2; ++d0) { s16x4 lo[4], hi[4];
#pragma unroll
        for (int ks = 0; ks < 4; ++ks) {
            asm volatile("ds_read_b64_tr_b16 %0,%1 offset:%c2" : "=&v"(lo[ks]) : "v"(vb), "i"(d0 * 4096 + ks * 1024) : "memory");
            asm volatile("ds_read_b64_tr_b16 %0,%1 offset:%c2" : "=&v"(hi[ks]) : "v"(vb), "i"(d0 * 4096 + ks * 1024 + 512) : "memory"); }
        asm volatile("s_waitcnt lgkmcnt(0)" ::: "memory"); SBAR();
#define PK(k) (bf16x8){lo[k][0], lo[k][1], lo[k][2], lo[k][3], hi[k][0], hi[k][1], hi[k][2], hi[k][3]}
        o[d0] = MF32(pa0, PK(0), o[d0]); o[d0] = MF32(pa1, PK(1), o[d0]); o[d0] = MF32(pa2, PK(2), o[d0]); o[d0] = MF32(pa3, PK(3), o[d0]);
#undef PK
    }
}

__device__ __forceinline__ void sb_task(const bf16* Qp, const bf16* Kp, const bf16* Vp, bf16* Op, int qs, char* wlds) {
    int tid = threadIdx.x; asm volatile("" : "+v"(tid));
    const int lane = tid & 63, r32 = lane & 31, hi = lane >> 5;
    bf16x8 qr[4];
#pragma unroll
    for (int j = 0; j < 4; ++j) qr[j] = *reinterpret_cast<const bf16x8*>(Qp + (size_t)(qs + r32) * 2048 + 16 * j + 8 * hi);
    f32x16 o[2]; o[0] = f32x16{}; o[1] = f32x16{};
    float Pc = 1.0f;
    const unsigned ldsb = (unsigned)__builtin_amdgcn_readfirstlane((unsigned)(uintptr_t)wlds);
    const int vb = (int)ldsb + ((lane >> 4) & 1) * 32 + (lane & 3) * 8 + (4 * hi + ((lane & 15) >> 2)) * 64;
    const char* vbase = uni_ptr(Vp);
    for (int k0 = qs; k0 >= 0; k0 -= 32) {
        const int tk = k0 >> 6, half = (k0 >> 5) & 1;
        if (k0 == qs || half == 1) {
#pragma unroll
            for (int w = 0; w < 8; ++w) glds16(vbase + (size_t)tk * 8192 + w * 1024, (unsigned)lane * 16u, ldsb + w * 1024);
        }
        bf16x8 kf[4];
#pragma unroll
        for (int j = 0; j < 4; ++j) kf[j] = *reinterpret_cast<const bf16x8*>(Kp + (size_t)tk * 4096 + (size_t)(2 * j + hi) * 512 + (half * 32 + r32) * 8);
        f32x16 C = f32x16{};
#pragma unroll
        for (int j = 0; j < 4; ++j) C = MF32(kf[j], qr[j], C);
        if (k0 == qs) {
#pragma unroll
            for (int r = 0; r < 16; ++r) if (crow(r, hi) >= r32) C[r] = -INFINITY;
        }
        float gp[4];
#pragma unroll
        for (int g = 0; g < 4; ++g) {
            float rr[4], bb[4];
#pragma unroll
            for (int i = 0; i < 4; ++i) { const float e = __builtin_amdgcn_exp2f(fminf(C[4 * g + i], 115.0f)); rr[i] = __builtin_amdgcn_rcpf(1.0f + e); bb[i] = e * rr[i]; }
            const float s2 = rr[3], s1 = rr[3] * rr[2], s0 = s1 * rr[1]; gp[g] = s0 * rr[0];
            C[4 * g + 3] = bb[3]; C[4 * g + 2] = bb[2] * s2; C[4 * g + 1] = bb[1] * s1; C[4 * g] = bb[0] * s0;
        }
        float GP[8];
#pragma unroll
        for (int g = 0; g < 4; ++g) { auto sw = __builtin_amdgcn_permlane32_swap(__float_as_uint(gp[g]), __float_as_uint(gp[g]), false, false); GP[2 * g] = __uint_as_float(sw[0]); GP[2 * g + 1] = __uint_as_float(sw[1]); }
        float GS[8]; float gs = Pc;
#pragma unroll
        for (int G = 7; G >= 0; --G) { GS[G] = gs; gs *= GP[G]; }
        Pc = gs;
        { const unsigned sel = 0u - (unsigned)hi;
#pragma unroll
          for (int g = 0; g < 4; ++g) { const float m0 = __uint_as_float((__float_as_uint(GS[2 * g]) & ~sel) | (__float_as_uint(GS[2 * g + 1]) & sel));
#pragma unroll
              for (int i = 0; i < 4; ++i) C[4 * g + i] *= m0; } }
        const u32x4 pw0 = (u32x4){cvtpk_s(C[0], C[1]), cvtpk_s(C[2], C[3]), cvtpk_s(C[4], C[5]), cvtpk_s(C[6], C[7])};
        const u32x4 pw1 = (u32x4){cvtpk_s(C[8], C[9]), cvtpk_s(C[10], C[11]), cvtpk_s(C[12], C[13]), cvtpk_s(C[14], C[15])};
        asm volatile("s_waitcnt vmcnt(0)" ::: "memory"); SBAR();
        { const int vbh = vb + half * 2048;
#pragma unroll
          for (int d0 = 0; d0 < 2; ++d0) { s16x4 lo[2], hh[2];
#pragma unroll
              for (int ks = 0; ks < 2; ++ks) {
                  asm volatile("ds_read_b64_tr_b16 %0,%1 offset:%c2" : "=&v"(lo[ks]) : "v"(vbh), "i"(d0 * 4096 + ks * 1024) : "memory");
                  asm volatile("ds_read_b64_tr_b16 %0,%1 offset:%c2" : "=&v"(hh[ks]) : "v"(vbh), "i"(d0 * 4096 + ks * 1024 + 512) : "memory"); }
              asm volatile("s_waitcnt lgkmcnt(0)" ::: "memory"); SBAR();
              o[d0] = MF32(__builtin_bit_cast(bf16x8, pw0), ((bf16x8){lo[0][0], lo[0][1], lo[0][2], lo[0][3], hh[0][0], hh[0][1], hh[0][2], hh[0][3]}), o[d0]);
              o[d0] = MF32(__builtin_bit_cast(bf16x8, pw1), ((bf16x8){lo[1][0], lo[1][1], lo[1][2], lo[1][3], hh[1][0], hh[1][1], hh[1][2], hh[1][3]}), o[d0]); } }
        if (__all(Pc < 0x1p-134f)) break;
    }
    asm volatile("s_waitcnt vmcnt(0)" ::: "memory");
#pragma unroll
    for (int r = 0; r < 16; ++r)
#pragma unroll
        for (int d0 = 0; d0 < 2; ++d0) Op[(size_t)(qs + crow(r, hi)) * 1024 + 32 * d0 + r32] = (bf16)f2bf(o[d0][r]);
}
struct AttnArgs { const bf16* Q; const bf16* K; const bf16* V; bf16* O; const bf16* QA; const bf16* KA; int ldq, ldk, ldv, ldo, lda; float mref; const float* RT; const float* qn; };
template <int KS, bool FOX = false> struct Lay { static constexpr int KSLOTB = FOX ? (2 * KS - 1) * 1024 : KS * 2048, LDS_K = 0, LDS_V = NSLOT * KSLOTB, LDS_WS = LDS_V + NSLOT * VSLOTB, LDS_OST = LDS_WS + NW * 256, LDS_BYTES = LDS_OST + NW * 4096; };

template <int KS, bool FOX, bool NOSUB = false>
__device__ __forceinline__ void attn_unit(const AttnArgs& A, int qb, int tbeg, char* shm) {
    typedef Lay<KS, FOX> L;
    constexpr int KSLOTB = L::KSLOTB, LDS_K = L::LDS_K, LDS_V = L::LDS_V, LDS_WS = L::LDS_WS, LDS_OST = L::LDS_OST, NX = FOX ? 1 : 2 * KS - 8;
    int tid = threadIdx.x; asm volatile("" : "+v"(tid));
    const int lane = tid & 63, r32 = lane & 31, hi = lane >> 5; const int wid = __builtin_amdgcn_readfirstlane(tid >> 6);
    const int q0 = qb * QB;
    const unsigned lds0 = (unsigned)(uintptr_t)shm;
    float* wsf = (float*)(shm + LDS_WS) + wid * 64;
    const bool xk = (NX > 0) && (wid < NX);
    constexpr long KTILEB = (FOX ? 8 : 2 * KS) * 1024;
    const char* kbase = uni_ptr(A.K) + (long)tbeg * KTILEB + wid * 1024; const char* kbase2 = FOX ? uni_ptr(A.KA) + (long)tbeg * KVBLK * A.lda * 2 : kbase + 8 * 1024;
    const char* vbase = uni_ptr(A.V) + (long)tbeg * 8192 + wid * 1024;
    const unsigned koff = (unsigned)lane * 16u;
    const unsigned koff2 = FOX ? (unsigned)(lane * A.lda + wid * 8) * 2u : koff;
    const unsigned voff = (unsigned)lane * 16u;
    const long kst = KTILEB, kst2 = FOX ? (long)KVBLK * A.lda * 2 : kst, vst = 8192;
    const unsigned kdst = lds0 + LDS_K + wid * 1024, kdst2 = lds0 + LDS_K + (8 + wid) * 1024, vdst = lds0 + LDS_V + wid * 1024;
#define DMA_K(t, s) do { glds16(kbase + (long)(t) * kst, koff, (unsigned)__builtin_amdgcn_readfirstlane(kdst + (s) * KSLOTB)); \
        if (xk) glds16(kbase2 + (long)(t) * kst2, koff2, (unsigned)__builtin_amdgcn_readfirstlane(kdst2 + (s) * KSLOTB)); } while (0)
#define DMA_V(t, s) glds16(vbase + (long)(t) * vst, voff, (unsigned)__builtin_amdgcn_readfirstlane(vdst + (s) * VSLOTB))
#define WAITB(Na, Nb) do { if (xk) { WAIT_BAR(Nb); } else { WAIT_BAR(Na); } } while (0)
    const int vb0 = (int)(lds0 + LDS_V) + ((lane >> 4) & 1) * 32 + (lane & 3) * 8 + (4 * hi + ((lane & 15) >> 2)) * 64;
    const lds_cptr shm3 = (lds_cptr)shm; const lds_cptr kp0 = shm3 + LDS_K + hi * 1024 + r32 * 16;
    const lds_cptr kpa = shm3 + LDS_K + 8192 + r32 * 16 - (KS - 1) * 2048;
    const lds_cptr vp0 = shm3 + LDS_V + ((lane >> 4) & 1) * 32 + (lane & 3) * 8 + (4 * hi + ((lane & 15) >> 2)) * 64;
    bf16x8 kf[2 * KS];
    const int NT = (q0 + QB) / KVBLK - tbeg;
    DMA_K(0, 0); DMA_V(0, 0); DMA_K(1, 1);
    bf16x8 qr[KS];
    { const bf16* Qw = A.Q + (long)(q0 + wid * QBLK + r32) * A.ldq;
#pragma unroll
      for (int d0 = 0; d0 < (FOX ? KS - 1 : KS); ++d0) qr[d0] = *reinterpret_cast<const bf16x8*>(Qw + d0 * 16 + hi * 8);
      if (FOX) { qr[KS - 1] = *reinterpret_cast<const bf16x8*>(A.QA + (long)(q0 + wid * QBLK + r32) * A.lda); if (hi) qr[KS - 1] = bf16x8{0, 0, 0, 0, 0, 0, 0, 0}; } }
    if constexpr (!FOX && KS == 6) {
        float qf[6][8]; float ss = 0.f;
#pragma unroll
        for (int j = 0; j < 6; ++j) { const u32x4 w = __builtin_bit_cast(u32x4, qr[j]);
            qf[j][0] = __builtin_bit_cast(float, w.x << 16); qf[j][1] = __builtin_bit_cast(float, w.x & 0xffff0000u); qf[j][2] = __builtin_bit_cast(float, w.y << 16); qf[j][3] = __builtin_bit_cast(float, w.y & 0xffff0000u);
            qf[j][4] = __builtin_bit_cast(float, w.z << 16); qf[j][5] = __builtin_bit_cast(float, w.z & 0xffff0000u); qf[j][6] = __builtin_bit_cast(float, w.w << 16); qf[j][7] = __builtin_bit_cast(float, w.w & 0xffff0000u);
#pragma unroll
            for (int e = 0; e < 8; ++e) ss += qf[j][e] * qf[j][e]; }
        { auto rr = __builtin_amdgcn_permlane32_swap(__float_as_uint(ss), __float_as_uint(ss), false, false); ss = __uint_as_float(rr[0]) + __uint_as_float(rr[1]); }
        const float rn = 0.14724445f * __builtin_amdgcn_rsqf(ss * (1.0f / 96.0f) + 1e-6f);
        const float* rt = A.RT + (size_t)(q0 + wid * QBLK + r32) * 32 + 8 * hi;
#pragma unroll
        for (int j = 0; j < 4; ++j)
#pragma unroll
            for (int e = 0; e < 8; ++e) qf[j][e] *= rn * A.qn[16 * j + 8 * hi + e];
#pragma unroll
        for (int e = 0; e < 8; ++e) { const float r1 = qf[4][e] * rn * A.qn[64 + 8 * hi + e], r2 = qf[5][e] * rn * A.qn[80 + 8 * hi + e], c = rt[e], sn = rt[16 + e];
            qf[4][e] = r1 * c - r2 * sn; qf[5][e] = r2 * c + r1 * sn; }
#pragma unroll
        for (int j = 0; j < 6; ++j) { const u32x4 w = (u32x4){cvtpk_s(qf[j][0], qf[j][1]), cvtpk_s(qf[j][2], qf[j][3]), cvtpk_s(qf[j][4], qf[j][5]), cvtpk_s(qf[j][6], qf[j][7])}; qr[j] = __builtin_bit_cast(bf16x8, w); }
    }
    const float mref = (FOX || NOSUB) ? 0.f : A.mref;
    float l_reg = 0.f; f32x16 o[2]; o[0] = f32x16{}; o[1] = f32x16{};
    const f32x16 zz = f32x16{};
    const int qrel = wid * QBLK + r32;
#define CMASK(P0, P1, t) do { int jb_ = (t) - (NT - 4); if (jb_ >= 0) cmask<false>(P0, P1, jb_, qrel, hi); } while (0)
#define EX(v) __builtin_amdgcn_exp2f((v) - mref)
    f32x16 pA0, pA1, pB0, pB1;
    int s_prev = 0, s_cur = 0, s_next = 1;
#define ROT() do { s_prev = s_cur; s_cur = s_next; s_next = (s_next == NSLOT - 1) ? 0 : s_next + 1; } while (0)
    DMA_K(2, 2);
    WAITB(3, 5);
    { const lds_cptr kb = kp0;
#pragma unroll
      for (int d0 = 0; d0 < KS; ++d0) {
          const lds_cptr kq = (FOX && d0 == KS - 1) ? kpa : kb;
          const bf16x8 b0 = *(const __attribute__((address_space(3))) bf16x8*)(kq + d0 * 2048), b1 = *(const __attribute__((address_space(3))) bf16x8*)(kq + d0 * 2048 + 512);
          if (d0 == 0) { pA0 = MF32(b0, qr[0], zz); pA1 = MF32(b1, qr[0], zz); } else { pA0 = MF32(b0, qr[d0], pA0); pA1 = MF32(b1, qr[d0], pA1); } } }
    CMASK(pA0, pA1, 0);
#pragma unroll
    for (int r = 0; r < 16; ++r) { pA0[r] = EX(pA0[r]); pA1[r] = EX(pA1[r]); }
    WAITB(0, 0);
    DMA_K(3, 0); DMA_V(1, 1);
    ROT();
#pragma unroll
    for (int j = 0; j < KS; ++j) kload2(kf, ((FOX && j == KS - 1) ? kpa : kp0) + s_cur * KSLOTB, j);
    WAITB(2, 3);
    s16x4 vlo[8], vhi[8]; u32x4 pw0, pw1, pw2, pw3;
#define PKW(P, B) cvtpk_s(P[B], P[B + 1])
#define PAF(k) __builtin_bit_cast(bf16x8, pw##k)
#define VFR(i) (bf16x8){vlo[i][0], vlo[i][1], vlo[i][2], vlo[i][3], vhi[i][0], vhi[i][1], vhi[i][2], vhi[i][3]}
#define PIN(x) asm volatile("" : "+v"(x))
#define GAPA(MF, A0, A1, A2, A3, W0, W1, PW) do { MF; sacc += A0; sacc += A1; sacc += A2; sacc += A3; PIN(sacc); W0; W1; PIN(PW); SBAR(); } while (0)
#define GAPB(MF, X, B) do { MF; X[B] = EX(X[B]); X[B + 1] = EX(X[B + 1]); X[B + 2] = EX(X[B + 2]); X[B + 3] = EX(X[B + 3]); PIN(X); SBAR(); } while (0)
#define VRD(i) do { vlo[i] = vtr(vp_ + (((i) >> 2) * 4096 + ((i) & 3) * 1024)); vhi[i] = vtr(vp_ + (((i) >> 2) * 4096 + ((i) & 3) * 1024 + 512)); } while (0)
#define KRD(G, j) do { if constexpr (KS > (j)) { if (G) { kload2(kf, ((FOX && (j) == KS - 1) ? kpa : kp0) + s_next * KSLOTB, j); SBAR(); } } } while (0)
#define XQK(C0, C1, j) do { if constexpr (KS > (j)) { C0 = MF32(kf[2 * (j)], qr[j], C0); C1 = MF32(kf[2 * (j) + 1], qr[j], C1); SBAR(); } } while (0)
#define STEP(C0, C1, P0, P1, t, GK, GV, GL) do { SBAR(); \
    const lds_cptr vp_ = vp0 + s_prev * VSLOTB; \
    VRD(0); SBAR(); float sacc = (P0[0] + P0[1]); \
    GAPA(C0 = MF32(kf[0], qr[0], zz), P0[2], P0[3], P0[4], P0[5],     pw0[0] = PKW(P0, 0), pw0[1] = PKW(P0, 2), pw0); \
    VRD(4); SBAR(); GAPA(C1 = MF32(kf[1], qr[0], zz), P0[6], P0[7], P0[8], P0[9],     pw0[2] = PKW(P0, 4), pw0[3] = PKW(P0, 6), pw0); \
    VRD(1); SBAR(); GAPA(C0 = MF32(kf[2], qr[1], C0),   P0[10], P0[11], P0[12], P0[13], pw1[0] = PKW(P0, 8), pw1[1] = PKW(P0, 10), pw1); \
    VRD(5); SBAR(); GAPA(C1 = MF32(kf[3], qr[1], C1),   P0[14], P0[15], P1[0], P1[1],   pw1[2] = PKW(P0, 12), pw1[3] = PKW(P0, 14), pw1); \
    VRD(2); SBAR(); GAPA(C0 = MF32(kf[4], qr[2], C0),   P1[2], P1[3], P1[4], P1[5],     pw2[0] = PKW(P1, 0), pw2[1] = PKW(P1, 2), pw2); \
    VRD(6); SBAR(); GAPA(C1 = MF32(kf[5], qr[2], C1),   P1[6], P1[7], P1[8], P1[9],     pw2[2] = PKW(P1, 4), pw2[3] = PKW(P1, 6), pw2); \
    VRD(3); SBAR(); GAPA(C0 = MF32(kf[6], qr[3], C0),   P1[10], P1[11], P1[12], P1[13], pw3[0] = PKW(P1, 8), pw3[1] = PKW(P1, 10), pw3); \
    VRD(7); SBAR(); GAPA(C1 = MF32(kf[7], qr[3], C1),   P1[14], P1[15], 0.f, 0.f,       pw3[2] = PKW(P1, 12), pw3[3] = PKW(P1, 14), pw3); \
    XQK(C0, C1, 4); XQK(C0, C1, 5); \
    l_reg += sacc; \
    if (GK) { DMA_K((t) + 3, s_cur); } if (GV) { DMA_V((t) + 1, s_next); } \
    CMASK(C0, C1, t); \
    SBAR(); \
    GAPB(o[0] = MF32(PAF(0), VFR(0), o[0]), C0, 0); \
    GAPB(o[1] = MF32(PAF(0), VFR(4), o[1]), C0, 4); \
    KRD(GL, 0); GAPB(o[0] = MF32(PAF(1), VFR(1), o[0]), C0, 8); \
    KRD(GL, 1); GAPB(o[1] = MF32(PAF(1), VFR(5), o[1]), C0, 12); \
    KRD(GL, 2); GAPB(o[0] = MF32(PAF(2), VFR(2), o[0]), C1, 0); \
    KRD(GL, 3); GAPB(o[1] = MF32(PAF(2), VFR(6), o[1]), C1, 4); \
    KRD(GL, 4); GAPB(o[0] = MF32(PAF(3), VFR(3), o[0]), C1, 8); \
    KRD(GL, 5); GAPB(o[1] = MF32(PAF(3), VFR(7), o[1]), C1, 12); \
    } while (0)
    int t = 1;
#undef CMASK
#define CMASK(P0, P1, t) do {} while (0)
    for (; t + 5 < NT; t += 2) {
        STEP(pB0, pB1, pA0, pA1, t, true, true, true);     WAITB(2, 3); ROT();
        STEP(pA0, pA1, pB0, pB1, t + 1, true, true, true); WAITB(2, 3); ROT();
    }
#undef CMASK
#define CMASK(P0, P1, t) do { int jb_ = (t) - (NT - 4); if (jb_ >= 0) cmask<false>(P0, P1, jb_, qrel, hi); } while (0)
#define ENDW(tt) do { if ((tt) + 3 < NT) { WAITB(2, 3); } else if ((tt) + 2 < NT) { WAITB(1, 1); } else { WAITB(0, 0); } } while (0)
    for (; t + 1 < NT; t += 2) {
        STEP(pB0, pB1, pA0, pA1, t, (t + 3 < NT), (t + 1 < NT), (t + 1 < NT));     ENDW(t);     ROT();
        STEP(pA0, pA1, pB0, pB1, t + 1, (t + 4 < NT), (t + 2 < NT), (t + 2 < NT)); ENDW(t + 1); ROT();
    }
    STEP(pB0, pB1, pA0, pA1, NT - 1, false, false, false);
    { float sacc = pB0[0] + pB0[1];
#pragma unroll
      for (int r = 2; r < 16; ++r) sacc += pB0[r];
#pragma unroll
      for (int r = 0; r < 16; ++r) sacc += pB1[r];
      l_reg += sacc;
      pw0 = (u32x4){PKW(pB0, 0), PKW(pB0, 2), PKW(pB0, 4), PKW(pB0, 6)}; pw1 = (u32x4){PKW(pB0, 8), PKW(pB0, 10), PKW(pB0, 12), PKW(pB0, 14)};
      pw2 = (u32x4){PKW(pB1, 0), PKW(pB1, 2), PKW(pB1, 4), PKW(pB1, 6)}; pw3 = (u32x4){PKW(pB1, 8), PKW(pB1, 10), PKW(pB1, 12), PKW(pB1, 14)};
      SBAR(); pv(o, vb0 + s_cur * VSLOTB, PAF(0), PAF(1), PAF(2), PAF(3)); }
#undef PKW
#undef PAF
#undef VFR
#undef PIN
#undef GAPA
#undef GAPB
#undef VRD
#undef KRD
#undef XQK
#undef STEP
#undef ENDW
    { auto rr = __builtin_amdgcn_permlane32_swap(__float_as_uint(l_reg), __float_as_uint(l_reg), false, false); l_reg = __uint_as_float(rr[0]) + __uint_as_float(rr[1]); }
    if (hi == 0) wsf[32 + r32] = l_reg; asm volatile("s_waitcnt lgkmcnt(0)" ::: "memory");
    float rli[16];
#pragma unroll
    for (int r = 0; r < 16; ++r) rli[r] = __builtin_amdgcn_rcpf(wsf[32 + crow(r, hi)]);
    bf16* Ow = A.O + (long)(q0 + wid * QBLK) * A.ldo;
    { bf16* stg = (bf16*)(shm + LDS_OST) + wid * 2048;
#pragma unroll
      for (int r = 0; r < 16; ++r) { const int orow = crow(r, hi);
#pragma unroll
          for (int d0 = 0; d0 < 2; ++d0) stg[orow * 64 + d0 * 32 + r32] = (bf16)f2bf(o[d0][r] * rli[r]); }
      asm volatile("s_waitcnt lgkmcnt(0)" ::: "memory");
#pragma unroll
      for (int i = 0; i < 4; ++i) { const int row = i * 8 + (lane >> 3), ch = lane & 7; const u32x4 v = *(const u32x4*)(stg + row * 64 + ch * 8); pg8::st16(Ow + (long)row * A.ldo + ch * 8, v); } }
    asm volatile("s_waitcnt lgkmcnt(0)\n\ts_barrier" ::: "memory");
#undef DMA_K
#undef DMA_V
#undef WAITB
#undef CMASK
#undef EX
#undef ROT
}
#undef SBAR
#undef WAIT_BAR
}

#define XB_TMO      128
#define XB_XCNT(j)  (256  + 64 * (j))
#define XB_XSUB(j)  (1280 + 64 * (j))
#define XB_XGEN(j)  (2304 + 64 * (j))
#define XB_TOP      3328
#define XB_TOPGEN   3392
#define XCD_BAR_WORDS 3456
#define XB_SPIN_CAP (1u << 18)
__device__ __forceinline__ unsigned xb_ld(unsigned* p)              { return __hip_atomic_load(p, __ATOMIC_RELAXED, __HIP_MEMORY_SCOPE_AGENT); }
__device__ __forceinline__ unsigned xb_add(unsigned* p, unsigned v) { return __hip_atomic_fetch_add(p, v, __ATOMIC_RELAXED, __HIP_MEMORY_SCOPE_AGENT); }
__device__ __forceinline__ unsigned xb_xcc_id() { return (unsigned)__builtin_amdgcn_s_getreg((3 << 11) | 20) & 0xFu; }
#define XB_SPIN(cond, bar) do { unsigned _sp = 0; while (cond) { __builtin_amdgcn_s_sleep(1); \
    if ((++_sp & 255u) == 0u) { if (xb_ld(&(bar)[XB_TMO])) break; if (_sp > XB_SPIN_CAP) { atomicAdd(&(bar)[XB_TMO], 1u); break; } } } } while (0)
struct XcdBarrier { unsigned* bar; unsigned x; volatile LAS unsigned* st; };
__device__ __forceinline__ XcdBarrier xcd_barrier_post(unsigned* bar, volatile LAS unsigned* st) {
    XcdBarrier b; b.bar = bar; b.x = xb_xcc_id(); b.st = st;
    if (threadIdx.x == 0) (void)xb_add(&bar[XB_XCNT(b.x)], 1u);
    return b;
}
__device__ __forceinline__ void xcd_barrier_complete(unsigned* bar, unsigned x, unsigned& nloc, unsigned& nx) {
    const unsigned G = gridDim.x * gridDim.y * gridDim.z;
    unsigned sum, cnt, mine, sp = 0u;
    for (;;) {
        sum = 0u; cnt = 0u; mine = 0u;
#pragma unroll
        for (unsigned j = 0; j < 16; ++j) { const unsigned c = xb_ld(&bar[XB_XCNT(j)]); sum += c; cnt += (c > 0u) ? 1u : 0u; mine = (j == x) ? c : mine; }
        if (sum == G) break;
        __builtin_amdgcn_s_sleep(1);
        if ((++sp & 255u) == 0u) { if (xb_ld(&bar[XB_TMO])) break; if (sp > XB_SPIN_CAP) { atomicAdd(&bar[XB_TMO], 1u); break; } }
    }
    nloc = mine > 0u ? mine : 1u; nx = cnt > 0u ? cnt : 1u;
}
__device__ __forceinline__ void xcd_barrier(const XcdBarrier& b) {
    asm volatile("s_waitcnt vmcnt(0)" ::: "memory");
    __syncthreads();
    if (threadIdx.x == 64) { __builtin_amdgcn_fence(__ATOMIC_ACQUIRE, "agent"); asm volatile("s_waitcnt vmcnt(0)" ::: "memory"); }
    if (threadIdx.x == 0) {
        unsigned* bar = b.bar;
        __builtin_amdgcn_s_waitcnt(0);
        unsigned nloc = b.st[0], nx = b.st[1];
        if (nloc == 0u) { xcd_barrier_complete(bar, b.x, nloc, nx); b.st[0] = nloc; b.st[1] = nx; }
        const unsigned k = b.st[3] + 1u; b.st[3] = k;
        const unsigned old = xb_add(&bar[XB_XSUB(b.x)], 1u);
        if (old + 1u == k * nloc) {
            __builtin_amdgcn_fence(__ATOMIC_RELEASE, "agent");
            asm volatile("s_waitcnt vmcnt(0)" ::: "memory");
            (void)xb_add(&bar[XB_TOP], 1u);
        }
        XB_SPIN(xb_ld(&bar[XB_TOP]) < k * nx, bar);
    }
    __syncthreads();
}

struct Args { const void* in[25]; float* out; unsigned char* ws; int ph_lo, ph_hi, li, pad; };
struct Frame {
    LAS unsigned char* lds; volatile LAS unsigned* MISC; gu32* ctl;
    int tid, lane, wave, vcu, G;
};
__device__ __forceinline__ float wave_sum(float v) {
#pragma unroll
    for (int o = 1; o < 64; o <<= 1) v += __shfl_xor(v, o);
    return v;
}

enum { MAT_W0IN = 0, MAT_UP0, MAT_WO0, MAT_GU0, MAT_WD0, MAT_W1IN, MAT_WO1, MAT_GU1, MAT_WD1, NMAT };
template <bool RSC>
__device__ __forceinline__ void conv_body(const float* src, int ldw, const float* rs8, float csc, bf16* dst, int Kd, int nsub) {
#pragma unroll
    for (int j = 0; j < 4; ++j) {
        if (j < nsub) {
            f32x4 v[8]; f32x4 r0 = {1.f, 1.f, 1.f, 1.f}, r1 = {1.f, 1.f, 1.f, 1.f};
#pragma unroll
            for (int i = 0; i < 8; ++i) v[i] = __builtin_nontemporal_load((const GAS f32x4*)(src + (size_t)(64 * j + i) * ldw));
            if (RSC) { r0 = *(const GAS f32x4*)(rs8 + 64 * j); r1 = *(const GAS f32x4*)(rs8 + 64 * j + 4); }
            const float sc[8] = {r0[0] * csc, r0[1] * csc, r0[2] * csc, r0[3] * csc, r1[0] * csc, r1[1] * csc, r1[2] * csc, r1[3] * csc};
#pragma unroll
            for (int r = 0; r < 4; ++r) { v4u o; o.x = pk2(v[0][r] * sc[0], v[1][r] * sc[1]); o.y = pk2(v[2][r] * sc[2], v[3][r] * sc[3]); o.z = pk2(v[4][r] * sc[4], v[5][r] * sc[5]); o.w = pk2(v[6][r] * sc[6], v[7][r] * sc[7]);
                pg8::st16(dst + (size_t)r * Kd + 64 * j, o); }
        } else {
#pragma unroll
            for (int r = 0; r < 4; ++r) *(GAS v4u*)(dst + (size_t)r * Kd + 64 * j) = (v4u){0u, 0u, 0u, 0u};
        }
    }
}
__device__ __forceinline__ void conv_task(const Args& a, int mat, int it, int lane) {
    const float* const* in = (const float* const*)a.in; unsigned char* ws = a.ws;
    int Kd = 0, Nd = 0; bf16* WT = nullptr;
    switch (mat) {
        case MAT_W0IN: Kd = 1024; Nd = 2048; WT = (bf16*)(ws + WS_W0IN); break;
        case MAT_UP0:  Kd = 256;  Nd = 1792; WT = (bf16*)(ws + WS_UP0); break;
        case MAT_WO0:  Kd = 1024; Nd = 1024; WT = (bf16*)(ws + WS_WO0); break;
        case MAT_GU0:  Kd = 1024; Nd = 5632; WT = (bf16*)(ws + WS_GU0); break;
        case MAT_WD0:  Kd = 2816; Nd = 1024; WT = (bf16*)(ws + WS_WD0); break;
        case MAT_W1IN: Kd = 1024; Nd = 3072; WT = (bf16*)(ws + WS_W1IN); break;
        case MAT_WO1:  Kd = 1024; Nd = 1024; WT = (bf16*)(ws + WS_WO1); break;
        case MAT_GU1:  Kd = 1024; Nd = 5632; WT = (bf16*)(ws + WS_GU1); break;
        default:       Kd = 2816; Nd = 1024; WT = (bf16*)(ws + WS_WD1); break;
    }
    const int nblk = Nd / 32, kb = it / nblk, nb = it % nblk, k0 = 256 * kb, n0 = 32 * nb;
    const float* W = in[3]; const float* rsc = nullptr; int ldw = 0, col0 = -1, Ksrc = 0; float csc = 1.0f;
    switch (mat) {
        case MAT_W0IN: W = in[3]; ldw = 1952; Ksrc = 1024; rsc = in[2];
            if (n0 < 1536) { col0 = 416 + n0; if (n0 < 512) csc = C2_64; } else if (n0 < 1792) col0 = n0 - 1536; else if (n0 < 1920) col0 = 256 + (n0 - 1792); else if (n0 < 1952) col0 = 384 + (n0 - 1920);
            break;
        case MAT_UP0:
            if (n0 < 768) { W = in[5]; ldw = 768; Ksrc = 256; rsc = in[4]; col0 = n0; }
            else { W = in[7]; ldw = 1024; Ksrc = 128; rsc = in[6]; const int n1 = n0 - 768;
                if (n1 < 512) { const int tp = n1 >> 8, r = n1 & 255, bj = r >> 7, wc = (r >> 5) & 3; col0 = (4 * tp + wc) * 128 + 32 * bj; }
                else { const int n2 = n1 - 512; col0 = (n2 >> 6) * 128 + 64 + (n2 & 63); } }
            break;
        case MAT_WO0: W = in[10]; ldw = 1024; Ksrc = 1024; col0 = n0; break;
        case MAT_GU0: { const int pn = n0 >> 8, r = n0 & 255; W = (r >> 7) ? in[13] : in[12]; ldw = 2816; Ksrc = 1024; rsc = in[11]; col0 = pn * 128 + (r & 127); } break;
        case MAT_WD0: W = in[14]; ldw = 1024; Ksrc = 2816; col0 = n0; break;
        case MAT_W1IN: W = in[16]; ldw = 3088; Ksrc = 1024; rsc = in[15];
            if (n0 < 2048) { const int base = (n0 >= 1024) ? 1024 : 0, n1 = n0 & 1023, pn = n1 >> 8, r = n1 & 255, bj = r >> 7, wc = (r >> 5) & 3; col0 = base + 64 * (4 * pn + wc) + 32 * bj; }
            else col0 = n0;
            break;
        case MAT_WO1: W = in[20]; ldw = 1024; Ksrc = 1024; col0 = n0; break;
        case MAT_GU1: { const int pn = n0 >> 8, r = n0 & 255; W = (r >> 7) ? in[23] : in[22]; ldw = 2816; Ksrc = 1024; rsc = in[21]; col0 = pn * 128 + (r & 127); } break;
        default: W = in[24]; ldw = 1024; Ksrc = 2816; col0 = n0; break;
    }
    const int ng = lane & 7, ks = lane >> 3;
    int nsub = (col0 < 0) ? 0 : (Ksrc - k0) / 64; nsub = nsub < 0 ? 0 : (nsub > 4 ? 4 : nsub);
    if (col0 < 0) col0 = 0;
    const float* src = W + (size_t)(k0 + 8 * ks) * ldw + col0 + 4 * ng;
    bf16* dst = WT + (size_t)(n0 + 4 * ng) * Kd + k0 + 8 * ks;
    if (rsc) conv_body<true>(src, ldw, rsc + k0 + 8 * ks, csc, dst, Kd, nsub); else conv_body<false>(src, ldw, nullptr, csc, dst, Kd, nsub);
}
__device__ __forceinline__ void p0_prologue(Frame& F, const Args& a) {
    const int gw = F.vcu * NWAVES + F.wave, NGW = F.G * NWAVES;
    constexpr int cnt[NMAT] = {64 * 4, 56 * 1, 32 * 4, 176 * 4, 32 * 11, 96 * 4, 32 * 4, 176 * 4, 32 * 11};
    constexpr int NITEMS = cnt[0] + cnt[1] + cnt[2] + cnt[3] + cnt[4] + cnt[5] + cnt[6] + cnt[7] + cnt[8];
    for (int it = gw; it < NITEMS; it += NGW) {
        int r = it, mat = 0;
#pragma unroll
        for (int m = 0; m < NMAT - 1; ++m) { if (mat == m && r >= cnt[m]) { r -= cnt[m]; mat = m + 1; } }
        conv_task(a, mat, r, F.lane);
    }
    { const float* W = (const float*)a.in[16]; const float* g = (const float*)a.in[15]; bf16* WF = (bf16*)(a.ws + WS_WF);
      for (int i = (F.vcu * NWAVES + F.wave) * 64 + F.lane; i < 16 * 1024; i += F.G * NWAVES * 64) { const int j = i >> 10, k = i & 1023; WF[i] = (bf16)f2bf(W[(size_t)k * 3088 + 3072 + j] * g[k]); } }
    { const int* pos = (const int*)a.in[1]; float* RT = (float*)(a.ws + WS_ROPE);
      for (int i = (F.vcu * NWAVES + F.wave) * 64 + F.lane; i < T * 16; i += F.G * NWAVES * 64) { const int t = i >> 4, k = i & 15;
          const float ang = (float)pos[t] * powf(10000.0f, -(float)k / 16.0f); RT[(size_t)t * 32 + k] = cosf(ang); RT[(size_t)t * 32 + 16 + k] = sinf(ang); } }
    { const float* x = (const float*)a.in[0]; bf16* XB = (bf16*)(a.ws + WS_XB); float* ssq = (float*)(a.ws + WS_SSQX);
      for (int m = gw; m < T; m += NGW) {
          const GAS f32x4* xr = (const GAS f32x4*)(x + (size_t)m * D) + F.lane; f32x4 v[4]; float s = 0.f;
#pragma unroll
          for (int j = 0; j < 4; ++j) { v[j] = __builtin_nontemporal_load(xr + 64 * j); s += (v[j].x * v[j].x + v[j].y * v[j].y) + (v[j].z * v[j].z + v[j].w * v[j].w); }
          s = wave_sum(s);
          GAS unsigned long long* o8 = (GAS unsigned long long*)(XB + (size_t)m * D) + F.lane;
#pragma unroll
          for (int j = 0; j < 4; ++j) o8[64 * j] = (unsigned long long)pk2(v[j].x, v[j].y) | ((unsigned long long)pk2(v[j].z, v[j].w) << 32);
          if (F.lane < 4) ssq[(size_t)m * 4 + F.lane] = (F.lane == 0) ? s : 0.f;
      } }
}

__device__ __forceinline__ float fox_mref(const float* qg, const float* kg, int lane_) {
    int lane = lane_; asm volatile("" : "+v"(lane));
    float a = fabsf(qg[lane]), b = fabsf(kg[lane]);
#pragma unroll
    for (int o = 1; o < 64; o <<= 1) { a = fmaxf(a, __shfl_xor(a, o)); b = fmaxf(b, __shfl_xor(b, o)); }
    return 64.0f * C2_64 * a * b * 1.02f + 0.25f;
}
__device__ __forceinline__ float mla_mref(const float* qg, const float* kg, int lane_) {
    int lane = lane_; asm volatile("" : "+v"(lane));
    float a = fmaxf(fabsf(qg[lane]), fabsf(qg[64 + (lane & 31)])), b = fmaxf(fabsf(kg[lane]), fabsf(kg[64 + (lane & 31)]));
#pragma unroll
    for (int o = 1; o < 64; o <<= 1) { a = fmaxf(a, __shfl_xor(a, o)); b = fmaxf(b, __shfl_xor(b, o)); }
    return 96.0f * C2_MLA * a * b * 1.02f + 0.25f;
}
__device__ __forceinline__ void split3(float x, unsigned& h, unsigned& m, unsigned& l) {
    h = f2bf(x); const float r1 = x - __builtin_bit_cast(float, h << 16); m = f2bf(r1); const float r2 = r1 - __builtin_bit_cast(float, m << 16); l = f2bf(r2);
}
__global__ void __launch_bounds__(NWAVES * 64, 2) mk_fwd(Args args) {
    extern __shared__ __attribute__((aligned(16))) unsigned char lds[];
    Frame F;
    F.lds = (LAS unsigned char*)lds;
    F.MISC = (volatile LAS unsigned*)(F.lds + MISC_OFF);
    F.tid = threadIdx.x; F.lane = F.tid & 63; F.wave = __builtin_amdgcn_readfirstlane(F.tid >> 6);
    F.G = gridDim.x; { const int bx = blockIdx.x; F.vcu = (F.G % 8 == 0) ? (bx % 8) * (F.G / 8) + bx / 8 : bx; }
    unsigned char* ws = args.ws;
    F.ctl = (gu32*)(ws + WS_CTL);
    for (int u = F.tid; u < (LDS_BYTES - LDSCTL_OFF) / 4; u += NWAVES * 64) ((LAS unsigned*)(F.lds + LDSCTL_OFF))[u] = 0u;
    __syncthreads();
    XcdBarrier bar; bar.bar = (unsigned*)(F.ctl + CW_BAR) + args.li * XCD_BAR_WORDS; bar.x = 0; bar.st = nullptr;
    if (N_LAUNCHES == 1) bar = xcd_barrier_post((unsigned*)(F.ctl + CW_BAR) + args.li * XCD_BAR_WORDS, F.MISC + 8);
#define GRID_BAR() do { if (N_LAUNCHES == 1) xcd_barrier(bar); } while (0)
    const int lo = args.ph_lo, hi = args.ph_hi;
#ifndef PHASE_MASK
#define PHASE_MASK 0xffff
#endif
#define IN(k) (((PHASE_MASK >> (k)) & 1) && lo <= (k) && (k) < hi)
#define BOTH(k) (IN(k) && IN((k) + 1))
    const float* const* in = (const float* const*)args.in;
    bf16* XB = (bf16*)(ws + WS_XB); bf16* OB = (bf16*)(ws + WS_O);
    float* SSQX = (float*)(ws + WS_SSQX); float* SSQC = (float*)(ws + WS_SSQC); float* SSQKV = (float*)(ws + WS_SSQKV); float* SSQKR = (float*)(ws + WS_SSQKV + 256 * 1024);
    bf16* PROJ0 = (bf16*)(ws + R_PROJ0); bf16* KNOPE = (bf16*)(ws + R_KNOPE); bf16* HB = (bf16*)(ws + R_H);
    bf16* Q1 = (bf16*)(ws + R_Q1); bf16* K1 = (bf16*)(ws + R_K1); bf16* V1 = (bf16*)(ws + R_V1);
    bf16* QM = (bf16*)((unsigned char*)args.out + DO_QM); bf16* KM = (bf16*)((unsigned char*)args.out + DO_KM); bf16* VM = (bf16*)((unsigned char*)args.out + DO_VM);
    float* LOGF = (float*)(ws + WS_LOGF); float* CT = (float*)(ws + WS_DEC); bf16* QAUG = (bf16*)(ws + WS_QAUG); bf16* KAUG = (bf16*)(ws + WS_KAUG);

    if (IN(0)) { p0_prologue(F, args); if (BOTH(0)) GRID_BAR(); }
    if (IN(1)) {
        pg8::Gemm g{XB, (const bf16*)(ws + WS_W0IN), T, 2048, 1024, 1024, 1 << 30, 0}; pg8::StaticOrder S; S.init(T, 2048, F.G, (int)blockIdx.x);
        pg8::EpiProj0 E{PROJ0, (bf16*)(ws + WS_SBK), (bf16*)(ws + WS_SBV), SSQX, SSQC, SSQKV, SSQKR};
        pg8::gemm_phase<pg8::EpiProj0, pg8::StaticOrder, true>(F.lds + RING_OFF, g, S, E);
        if (BOTH(1)) GRID_BAR();
    }
    if (IN(2)) {
        pg8::Gemm g{PROJ0 + 1536, (const bf16*)(ws + WS_UP0), T, 1792, 256, 2048, 3, 256}; pg8::StaticOrder S; S.init(T, 1792, F.G, (int)blockIdx.x);
        pg8::EpiUp E{QM, KM, VM, SSQC, SSQKV, SSQKR, PROJ0, (const float*)(ws + WS_ROPE), in[9]};
        pg8::gemm_phase<pg8::EpiUp, pg8::StaticOrder, true>(F.lds + RING_OFF, g, S, E);
        if (BOTH(2)) GRID_BAR();
    }
    if (IN(4)) {
        { const float mref = mla_mref(in[8], in[9], F.lane);
          for (int v = F.vcu; v < 256; v += F.G) {
              const int bh = v >> 3, s8 = v & 7, b = bh >> 3, h = bh & 7; const size_t rb = (size_t)b * SEQ;
              att::AttnArgs A{QM + rb * 768 + h * 96, KM + (size_t)bh * 64 * 6144, VM + (size_t)bh * 64 * 4096, OB + rb * 1024 + h * 64, nullptr, nullptr, 768, 768, 512, 1024, 0, mref, (const float*)(ws + WS_ROPE) + rb * 32, in[8]};
              if (__builtin_amdgcn_readfirstlane((int)(mref <= 64.0f))) {
#pragma unroll 1
                  for (int i = 0; i < 2; ++i) att::attn_unit<6, false, true>(A, i == 0 ? s8 : 15 - s8, 0, (char*)lds + RING_OFF);
              } else {
#pragma unroll 1
                  for (int i = 0; i < 2; ++i) att::attn_unit<6, false, false>(A, i == 0 ? s8 : 15 - s8, 0, (char*)lds + RING_OFF);
              }
          } }
        for (int wt = F.vcu; wt < 512; wt += F.G) {
            const int bh = wt >> 4, b = bh >> 3, h = bh & 7, qs = (wt & 15) * 256 + F.wave * 32; const size_t rb = (size_t)b * SEQ;
            att::sb_task(PROJ0 + rb * 2048 + h * 64, (const bf16*)(ws + WS_SBK) + (size_t)bh * 64 * 4096, (const bf16*)(ws + WS_SBV) + (size_t)bh * 64 * 4096, OB + rb * 1024 + 512 + h * 64, qs, (char*)lds + RING_OFF + F.wave * 8192);
        }
        if (BOTH(4)) GRID_BAR();
    }
    if (IN(5)) {
        pg8::Gemm g{OB, (const bf16*)(ws + WS_WO0), T, 1024, 1024, 1024, 1 << 30, 0}; pg8::StaticOrder S; S.init(T, 1024, F.G, (int)blockIdx.x);
        pg8::EpiRes<true, false> E{XB, nullptr, XB, SSQX};
        pg8::gemm_phase<pg8::EpiRes<true, false>, pg8::StaticOrder, false>(F.lds + RING_OFF, g, S, E);
        if (BOTH(5)) GRID_BAR();
    }
    if (IN(6)) {
        pg8::Gemm g{XB, (const bf16*)(ws + WS_GU0), T, 5632, 1024, 1024, 1 << 30, 0}; pg8::HalfTailOrder S; S.init(T, 5632, F.G, (int)blockIdx.x);
        pg8::EpiGU E{HB, SSQX};
        pg8::gemm_phase<pg8::EpiGU, pg8::HalfTailOrder, true>(F.lds + RING_OFF, g, S, E);
        if (BOTH(6)) GRID_BAR();
    }
    if (IN(7)) {
        pg8::Gemm g{HB, (const bf16*)(ws + WS_WD0), T, 1024, 2816, 2816, 1 << 30, 0}; pg8::StaticOrder S; S.init(T, 1024, F.G, (int)blockIdx.x);
        pg8::EpiRes<true, false> E{XB, nullptr, XB, SSQX};
        pg8::gemm_phase<pg8::EpiRes<true, false>, pg8::StaticOrder, false>(F.lds + RING_OFF, g, S, E);
        if (BOTH(7)) GRID_BAR();
    }
    if (IN(8)) {
        {
          const bf16* WF = (const bf16*)(ws + WS_WF); const float* fb = in[17];
          const int fr = F.lane & 15, fq = F.lane >> 4, kh = F.wave & 1, pr = F.wave >> 1;
          LAS f32x4* xch = (LAS f32x4*)(F.lds + RING_OFF);
          for (int rg0 = F.vcu * 4; rg0 < T / 16; rg0 += F.G * 4) {
              const int rg = rg0 + pr;
              const bf16* ap = XB + (size_t)(rg * 16 + fr) * 1024 + 8 * fq + 512 * kh; const bf16* bp = WF + (size_t)fr * 1024 + 8 * fq + 512 * kh;
              pg8::bf16x8 av[16], bv[16];
#pragma unroll
              for (int kk = 0; kk < 16; ++kk) { av[kk] = *(const pg8::bf16x8*)(ap + 32 * kk); bv[kk] = *(const pg8::bf16x8*)(bp + 32 * kk); }
              pg8::f32x4 c = {0.f, 0.f, 0.f, 0.f};
#pragma unroll
              for (int kk = 0; kk < 16; ++kk) c = __builtin_amdgcn_mfma_f32_16x16x32_bf16(av[kk], bv[kk], c, 0, 0, 0);
              if (kh) xch[pr * 64 + F.lane] = c;
              __syncthreads();
              if (!kh) {
                  c += xch[pr * 64 + F.lane];
                  const int row0 = rg * 16 + 4 * fq, b = row0 / SEQ, s0 = row0 % SEQ; const float bias = fb[fr]; f32x4 lf;
#pragma unroll
                  for (int r = 0; r < 4; ++r) { const float xx = c[r] * pg8::rs4(SSQX, row0 + r, 1.0f / 1024.0f) + bias; lf[r] = fminf(xx, 0.f) - log1pf(expf(-fabsf(xx))); }
                  float* dst = LOGF + ((size_t)(b * 16 + fr)) * SEQ + s0;
                  asm volatile("global_store_dwordx4 %0, %1, off sc1" :: "v"(dst), "v"(lf) : "memory");
              }
              asm volatile("s_waitcnt vmcnt(0)" ::: "memory");
              __syncthreads();
              if (F.tid == 0) __hip_atomic_fetch_add((unsigned*)(F.ctl + CW_LOGF + 16 * ((rg0 * 16) / SEQ)), 4u, __ATOMIC_RELAXED, __HIP_MEMORY_SCOPE_AGENT);
          } }
        pg8::Gemm g{XB, (const bf16*)(ws + WS_W1IN), T, 3072, 1024, 1024, 1 << 30, 0}; pg8::StaticOrder S; S.init(T, 3072, F.G, (int)blockIdx.x);
        pg8::EpiProj1 E{Q1, K1, V1, SSQX, in[18], in[19], C2_64, F.lds + RING_OFF + pg8::GAIN_LDS_OFF};
        pg8::gemm_phase<pg8::EpiProj1, pg8::StaticOrder, true>(F.lds + RING_OFF, g, S, E);
    }
    if (IN(9)) {
        LAS float* wsum = (LAS float*)(F.lds + RING_OFF); const float mref9 = fox_mref(in[18], in[19], F.lane);
        for (int u = F.vcu; u < 256; u += F.G) {
            const int sq = u >> 2, part = u & 3, s0 = part * 1024 + F.tid * 2; const float* lf = LOGF + (size_t)sq * SEQ;
            if (BOTH(8)) {
                if (F.tid == 0) { unsigned* cw = (unsigned*)(F.ctl + CW_LOGF + 16 * (sq >> 4)); unsigned sp = 0;
                    while (__hip_atomic_load(cw, __ATOMIC_RELAXED, __HIP_MEMORY_SCOPE_AGENT) < (unsigned)(SEQ / 16)) { __builtin_amdgcn_s_sleep(1); if (++sp > (1u << 22)) break; }
                    __builtin_amdgcn_fence(__ATOMIC_ACQUIRE, "agent"); }
                __syncthreads();
            }
            float pre = 0.f;
            for (int q = 0; q < part; ++q) { const float2 t2 = *(const float2*)(lf + q * 1024 + F.tid * 2); pre += t2.x + t2.y; }
            pre = wave_sum(pre);
            const float2 me = *(const float2*)(lf + s0); const float v0 = me.x, v1 = me.x + me.y;
            float inc = v1;
#pragma unroll
            for (int o = 1; o < 64; o <<= 1) { const float t = __shfl_up(inc, o); if (F.lane >= o) inc += t; }
            if (F.lane == 63) { wsum[F.wave] = inc; wsum[8 + F.wave] = pre; }
            __syncthreads();
            float basev = inc - v1;
            for (int w = 0; w < 8; ++w) { basev += wsum[8 + w]; if (w < F.wave) basev += wsum[w]; }
#pragma unroll
            for (int i = 0; i < 2; ++i) { const float c2 = (basev + (i ? v1 : v0)) * LOG2E; unsigned a0, a1, a2, b0, b1, b2; split3(c2 - mref9, a0, a1, a2); split3(-c2, b0, b1, b2);
                const size_t ro = ((size_t)sq * SEQ + s0 + i) * 8;
                *(v4u*)(QAUG + ro) = (v4u){a0 | (a1 << 16), a2 | 0x3F800000u, 0x3F803F80u, 0u};
                *(v4u*)(KAUG + ro) = (v4u){0x3F803F80u, 0x3F80u | (b0 << 16), b1 | (b2 << 16), 0u};
                if (((s0 + i) & 63) == 63) CT[sq * 64 + ((s0 + i) >> 6)] = c2; }
            __syncthreads();
        }
        if (BOTH(9)) GRID_BAR();
    }
    if (IN(10)) {
        static_assert(att::Lay<6>::LDS_BYTES <= RING_BYTES && att::Lay<5, true>::LDS_BYTES <= RING_BYTES, "attention LDS");
        const float mref = fox_mref(in[18], in[19], F.lane);
        for (;;) {
            if (F.tid == 0) F.MISC[16] = __hip_atomic_fetch_add((unsigned*)(F.ctl + CW_Q10), 1u, __ATOMIC_RELAXED, __HIP_MEMORY_SCOPE_AGENT);
            __syncthreads();
            const unsigned u = F.MISC[16];
            __syncthreads();
            if (u >= 1024u) break;
            const int qb = 15 - (int)(u >> 6), bh = (int)(u & 63u), b = bh >> 4, h = bh & 15; const size_t rb = (size_t)b * SEQ;
            att::AttnArgs A{Q1 + rb * 1024 + h * 64, K1 + (size_t)bh * 64 * 4096, V1 + (size_t)bh * 64 * 4096, OB + rb * 1024 + h * 64, QAUG + (size_t)bh * SEQ * 8, KAUG + (size_t)bh * SEQ * 8, 1024, 1024, 1024, 1024, 8, mref, nullptr, nullptr};
            const float c2prev = (qb == 0) ? 0.f : CT[bh * 64 + 4 * qb - 1];
            const bool skip = (F.lane < 4 * qb) && (c2prev - CT[bh * 64 + F.lane] < -136.0f);
            const unsigned long long keep = ~__ballot(skip);
            int tb = (int)__builtin_ctzll(keep) & ~1; tb = tb > 4 * qb ? 4 * qb : tb; tb = __builtin_amdgcn_readfirstlane(tb);
            att::attn_unit<5, true>(A, qb, tb, (char*)lds + RING_OFF);
        }
        if (BOTH(10)) GRID_BAR();
    }
    if (IN(11)) {
        pg8::Gemm g{OB, (const bf16*)(ws + WS_WO1), T, 1024, 1024, 1024, 1 << 30, 0}; pg8::StaticOrder S; S.init(T, 1024, F.G, (int)blockIdx.x);
        pg8::EpiRes<true, false> E{XB, nullptr, XB, SSQX};
        pg8::gemm_phase<pg8::EpiRes<true, false>, pg8::StaticOrder, false>(F.lds + RING_OFF, g, S, E);
        if (BOTH(11)) GRID_BAR();
    }
    if (IN(12)) {
        pg8::Gemm g{XB, (const bf16*)(ws + WS_GU1), T, 5632, 1024, 1024, 1 << 30, 0}; pg8::HalfTailOrder S; S.init(T, 5632, F.G, (int)blockIdx.x);
        pg8::EpiGU E{HB, SSQX};
        pg8::gemm_phase<pg8::EpiGU, pg8::HalfTailOrder, true>(F.lds + RING_OFF, g, S, E);
        if (BOTH(12)) GRID_BAR();
    }
    if (IN(13)) {
        pg8::Gemm g{HB, (const bf16*)(ws + WS_WD1), T, 1024, 2816, 2816, 1 << 30, 0}; pg8::StaticOrder S; S.init(T, 1024, F.G, (int)blockIdx.x);
        pg8::EpiRes<true, true> E{XB, args.out, nullptr, nullptr};
        pg8::gemm_phase<pg8::EpiRes<true, true>, pg8::StaticOrder, false>(F.lds + RING_OFF, g, S, E);
    }
#undef IN
#undef BOTH
}

extern "C" void kernel_launch(void* const* d_in, const int* in_sizes, int n_in, void* d_out, int out_size, void* d_ws, size_t ws_size, hipStream_t stream) {
    static int grid = 0;
    if (grid == 0) {
        if (n_in != 25 || in_sizes[0] != T * D || out_size != T * D || ws_size < WS_END) { fprintf(stderr, "kernel_launch: unexpected shapes (n_in %d, in0 %d, out %d, ws %zu)\n", n_in, n_in > 0 ? in_sizes[0] : -1, out_size, ws_size); grid = -1; return; }
        int dev = 0, cus = 0, per_cu = 0;
        if (hipGetDevice(&dev) != hipSuccess || hipDeviceGetAttribute(&cus, hipDeviceAttributeMultiprocessorCount, dev) != hipSuccess) { grid = -1; return; }
        if (hipFuncSetAttribute((const void*)mk_fwd, hipFuncAttributeMaxDynamicSharedMemorySize, LDS_BYTES) != hipSuccess) { fprintf(stderr, "kernel_launch: hipFuncSetAttribute failed\n"); grid = -1; return; }
        if (hipOccupancyMaxActiveBlocksPerMultiprocessor(&per_cu, (const void*)mk_fwd, NWAVES * 64, LDS_BYTES) != hipSuccess || per_cu < 1) { fprintf(stderr, "kernel_launch: occupancy query says %d blocks per CU\n", per_cu); per_cu = 1; }
        (void)hipGetLastError();
        grid = cus;
    }
    if (grid < 0) return;
    if (hipMemsetAsync((char*)d_ws + WS_CTL, 0, CTL_ZERO_BYTES, stream) != hipSuccess) return;
    Args a{};
    for (int i = 0; i < 25; ++i) a.in[i] = d_in[i];
    a.out = (float*)d_out; a.ws = (unsigned char*)d_ws;
#if defined(PROBE_PHASE)
    { int li = 0; a.ph_lo = 0; a.ph_hi = PROBE_PHASE + 1; a.li = li++; hipLaunchKernelGGL(mk_fwd, dim3(grid), dim3(NWAVES * 64), LDS_BYTES, stream, a);
      for (int r = 0; r < PROBE_REPS - 1; ++r) { a.ph_lo = PROBE_PHASE; a.ph_hi = PROBE_PHASE + 1; a.li = li++; hipLaunchKernelGGL(mk_fwd, dim3(grid), dim3(NWAVES * 64), LDS_BYTES, stream, a); }
      a.ph_lo = PROBE_PHASE; a.ph_hi = NPHASE; a.li = li++; hipLaunchKernelGGL(mk_fwd, dim3(grid), dim3(NWAVES * 64), LDS_BYTES, stream, a); }
#else
    if (N_LAUNCHES == 1) { a.ph_lo = 0; a.ph_hi = NPHASE; hipLaunchKernelGGL(mk_fwd, dim3(grid), dim3(NWAVES * 64), LDS_BYTES, stream, a); }
    else for (int p = 0; p < NPHASE; ++p) { a.ph_lo = p; a.ph_hi = p + 1; hipLaunchKernelGGL(mk_fwd, dim3(grid), dim3(NWAVES * 64), LDS_BYTES, stream, a); }
#endif
}
```

```cpp
#include <hip/hip_runtime.h>
#include <cstdio>
#include <cstdint>
#include <cmath>

#ifndef MK_N_LAUNCHES
#define MK_N_LAUNCHES 1
#endif

namespace pg8 {
#define PG8_LAS __attribute__((address_space(3)))
typedef unsigned short bf16_t;
typedef short bf16x8 __attribute__((ext_vector_type(8)));
typedef float f32x4 __attribute__((ext_vector_type(4)));
typedef unsigned u32x4 __attribute__((ext_vector_type(4)));
typedef unsigned u32x2 __attribute__((ext_vector_type(2)));
constexpr int BM = 256, BK = 64, HALF = 128, HTB = HALF * BK * 2, STAGE_BYTES = 8 * HTB, NXCD = 8, WGM = 8;
#ifndef MK_WT
#define MK_WT 0
#endif
__device__ __forceinline__ void st16(void* p, u32x4 v) {
#if MK_WT
    asm volatile("global_store_dwordx4 %0, %1, off sc1\n\ts_nop 1" :: "v"(p), "v"(v) : "memory");
#else
    *(u32x4*)p = v;
#endif
}
__device__ __forceinline__ void st8(void* p, u32x2 v) {
#if MK_WT
    asm volatile("global_store_dwordx2 %0, %1, off sc1\n\ts_nop 1" :: "v"(p), "v"(v) : "memory");
#else
    *(u32x2*)p = v;
#endif
}

__host__ __device__ __forceinline__ int lds_byte(int r, int c) { const int st = (r >> 4) * 2 + (c >> 5), rr = r & 15, cc = c & 31, ob = rr * 64 + cc * 2; return st * 1024 + (ob ^ (((ob >> 9) & 1) << 5)); }
__host__ __device__ __forceinline__ void stage_rc(int b, int& R, int& C) { const int st = b / 1024, sb = b % 1024, swz = sb ^ (((sb >> 9) & 1) << 5); R = (st >> 1) * 16 + swz / 64; C = (st & 1) * 32 + (swz % 64) / 2; }
__host__ __device__ __forceinline__ int perm32(int rho) { const int n = rho >> 4, i = rho & 15; return 8 * (i >> 2) + 4 * n + (i & 3); }

struct Unit { int pm, pn, half; };
struct Gemm { const bf16_t* A; const bf16_t* Bt; int M, N, K, lda, split_pn, split_off; int split_nt = 0; };

struct StaticOrder {
    int nM, nN, nwg, G, c, wgm;
    __host__ __device__ void init(int M, int N, int G_, int c_, int wgm_ = WGM) { nM = M / BM; nN = N / BM; nwg = nM * nN; G = G_; c = c_; wgm = wgm_; }
    __host__ __device__ bool next(int i, Unit& u) const {
        const long L = (long)i * G + c; if (L >= nwg) return false;
        int wgid = (int)L; { const int q = nwg / NXCD, r = nwg % NXCD, xcd = wgid % NXCD, off = wgid / NXCD; wgid = (xcd < r ? xcd * (q + 1) : r * (q + 1) + (xcd - r) * q) + off; }
        const int nig = wgm * nN, gid = wgid / nig, fm = gid * wgm, gsz = (nM - fm) < wgm ? (nM - fm) : wgm;
        u.pm = fm + ((wgid % nig) % gsz); u.pn = (wgid % nig) / gsz; u.half = 0; return true;
    }
};
struct HalfTailOrder : StaticOrder {
    __host__ __device__ bool next(int i, Unit& u) const {
        const int nfull = nwg / G;
        if (nwg - nfull * G != G / 2 || (G % 16) != 0) return StaticOrder::next(i, u);
        if (i < nfull) return StaticOrder::next(i, u);
        if (i > nfull) return false;
        const int k = c / NXCD, cc = (c % NXCD) + NXCD * (k >> 1);
        StaticOrder t = *this; t.c = cc; t.next(nfull, u); u.half = 1 + (k & 1); return true;
    }
};

typedef float f32x2_c __attribute__((ext_vector_type(2))); typedef __bf16 bf16x2_c __attribute__((ext_vector_type(2)));
__device__ __forceinline__ unsigned cvt_pk_bf16(float lo, float hi) { f32x2_c v = {lo, hi}; bf16x2_c b = __builtin_convertvector(v, bf16x2_c); return __builtin_bit_cast(unsigned, b); }
__device__ __forceinline__ float quad_sum(float x) {
    const auto a = __builtin_amdgcn_permlane32_swap(__builtin_bit_cast(unsigned, x), __builtin_bit_cast(unsigned, x), false, false);
    const float y = __builtin_bit_cast(float, (unsigned)a[0]) + __builtin_bit_cast(float, (unsigned)a[1]);
    const auto b = __builtin_amdgcn_permlane16_swap(__builtin_bit_cast(unsigned, y), __builtin_bit_cast(unsigned, y), false, false);
    return __builtin_bit_cast(float, (unsigned)b[0]) + __builtin_bit_cast(float, (unsigned)b[1]);
}
__device__ __forceinline__ float dot4(f32x4 v) { return (v[0] * v[0] + v[1] * v[1]) + (v[2] * v[2] + v[3] * v[3]); }
__device__ __forceinline__ float rs16(const float* ssq, int row, float invD) {
    const f32x4* p = (const f32x4*)(ssq + (size_t)row * 16); const f32x4 a = p[0], b = p[1], c = p[2], d = p[3];
    const float s = (((a[0] + a[1]) + (a[2] + a[3])) + ((b[0] + b[1]) + (b[2] + b[3]))) + (((c[0] + c[1]) + (c[2] + c[3])) + ((d[0] + d[1]) + (d[2] + d[3])));
    return __builtin_amdgcn_rsqf(s * invD + 1e-6f);
}
__device__ __forceinline__ float rs4(const float* ssq, int row, float invD) {
    const f32x4 a = *(const f32x4*)(ssq + (size_t)row * 4); return __builtin_amdgcn_rsqf(((a[0] + a[1]) + (a[2] + a[3])) * invD + 1e-6f);
}
__device__ __forceinline__ void rs8(const float* ssq, int row0, float invD, float (&rs)[8]) {
    f32x4 a[8];
#pragma unroll
    for (int i = 0; i < 8; ++i) a[i] = *(const f32x4*)(ssq + (size_t)(row0 + (i >> 2) * HALF + (i & 3) * 16) * 4);
#pragma unroll
    for (int i = 0; i < 8; ++i) rs[i] = __builtin_amdgcn_rsqf(((a[i][0] + a[i][1]) + (a[i][2] + a[i][3])) * invD + 1e-6f);
}
constexpr int SSQ_LDS_OFF = 131072 + 4096, SSQ_LDS_BYTES = 4096;
__device__ __forceinline__ void rs8_lds(const PG8_LAS unsigned char* ss, int rl0, float invD, float (&rs)[8]) {
    f32x4 a[8];
#pragma unroll
    for (int i = 0; i < 8; ++i) a[i] = *(const PG8_LAS f32x4*)(ss + (rl0 + (i >> 2) * HALF + (i & 3) * 16) * 16);
#pragma unroll
    for (int i = 0; i < 8; ++i) rs[i] = __builtin_amdgcn_rsqf(((a[i][0] + a[i][1]) + (a[i][2] + a[i][3])) * invD + 1e-6f);
}
__device__ __forceinline__ void rs4_lds(const PG8_LAS unsigned char* ss, int rl0, float invD, float (&rs)[4]) {
    f32x4 a[4];
#pragma unroll
    for (int i = 0; i < 4; ++i) a[i] = *(const PG8_LAS f32x4*)(ss + (rl0 + i * 16) * 16);
#pragma unroll
    for (int i = 0; i < 4; ++i) rs[i] = __builtin_amdgcn_rsqf(((a[i][0] + a[i][1]) + (a[i][2] + a[i][3])) * invD + 1e-6f);
}
template <int N> __device__ __forceinline__ void wait_v() { asm volatile("s_waitcnt vmcnt(%0)" :: "n"(N) : "memory"); }
constexpr int GAIN_LDS_OFF = SSQ_LDS_OFF + 2 * SSQ_LDS_BYTES;
__device__ __forceinline__ u32x4 pack8(f32x4 v0, f32x4 v1) { u32x4 w; w.x = cvt_pk_bf16(v0[0], v0[1]); w.y = cvt_pk_bf16(v0[2], v0[3]); w.z = cvt_pk_bf16(v1[0], v1[1]); w.w = cvt_pk_bf16(v1[2], v1[3]); return w; }
__device__ __forceinline__ size_t vimg_off(int bh, int s, int d) { return ((size_t)bh * 64 + (s >> 6)) * 4096 + (size_t)(((d >> 5) * 4 + ((s & 63) >> 4)) * 512 + (s & 15) * 32 + (d & 31)); }

struct EpiProj0 {
    static constexpr bool PERM = true, AFTER_DRAIN = false, SSQ_LDS = true, SPLIT = false;
    static constexpr int S0 = 0, S1 = 16;
    __device__ __forceinline__ const float* ssq_src(const Unit&) const { return ssqx; }
    bf16_t* O; bf16_t* SBK; bf16_t* SBV; const float* ssqx; float* ssq_cq; float* ssq_ckv; float* ssq_kr;
    __device__ __forceinline__ void init_lds(PG8_LAS unsigned char*, int) const {}
    __device__ __forceinline__ void wait_half0(const Unit& u, int wc) const { if (u.pn < 6) wait_v<6 + 8>(); else if (u.pn == 6 || wc != 0) wait_v<6 + 12>(); else wait_v<6 + 16>(); }
    template <int ai>
    __device__ __forceinline__ void half(const f32x4 (&acc)[2][2][4][2], const Unit& u, int wr, int wc, int fr_, int fq_, const PG8_LAS unsigned char* ss) const {
        int fr = fr_, fq = fq_; asm volatile("" : "+v"(fr), "+v"(fq));
        const int row0 = u.pm * BM + wr * 64 + fr, col0 = u.pn * BM + wc * 32 + 8 * fq;
        float rsv[4]; rs4_lds(ss, ai * HALF + wr * 64 + fr, 1.0f / 1024.0f, rsv);
#pragma unroll
            for (int m = 0; m < 4; ++m) {
                const int row = row0 + ai * HALF + m * 16; const float rs = rsv[m];
                float part[2];
#pragma unroll
                for (int bj = 0; bj < 2; ++bj) { const f32x4 v0 = acc[ai][bj][m][0] * rs, v1 = acc[ai][bj][m][1] * rs; part[bj] = 0.f; if (u.pn >= 6) part[bj] = dot4(v0) + dot4(v1);
                    if (u.pn == 2 || u.pn == 3) { const int cc = (u.pn - 2) * 256 + bj * HALF + wc * 32 + 8 * fq, hd = cc >> 6, ch = (cc & 63) >> 3;
                        st16(SBK + ((size_t)((row >> 12) * 8 + hd) * 64 + ((row & 4095) >> 6)) * 4096 + (size_t)ch * 512 + (size_t)(row & 63) * 8, pack8(v0, v1)); }
                    else if (u.pn == 4 || u.pn == 5) { const int cc = (u.pn - 4) * 256 + bj * HALF + wc * 32 + 8 * fq;
                        st16(SBV + vimg_off((row >> 12) * 8 + (cc >> 6), row & 4095, cc & 63), pack8(v0, v1)); }
                    else st16(O + (size_t)row * 2048 + col0 + bj * HALF, pack8(v0, v1)); }
                if (u.pn == 6 || u.pn == 7) { float p = (u.pn == 6) ? part[0] + part[1] : part[0]; p = quad_sum(p);
                    if (fq == 0) ((u.pn == 6) ? ssq_cq : ssq_ckv)[(size_t)row * 4 + wc] = p;
                    if (u.pn == 7 && wc == 0) { float p1 = part[1]; p1 = quad_sum(p1); if (fq == 0) ssq_kr[row] = p1; } }
            }
    }
};
struct EpiUp {
    static constexpr bool PERM = true, AFTER_DRAIN = false, SSQ_LDS = true, SPLIT = false;
    static constexpr int S0 = 0, S1 = 16;
    __device__ __forceinline__ const float* ssq_src(const Unit& u) const { return u.pn < 3 ? ssq_cq : ssq_ckv; }
    bf16_t* Q; bf16_t* KM; bf16_t* V; const float* ssq_cq; const float* ssq_ckv; const float* ssq_kr; const bf16_t* PROJ0; const float* RT; const float* kn;
    __device__ __forceinline__ void init_lds(PG8_LAS unsigned char*, int) const {}
    __device__ __forceinline__ void wait_half0(const Unit& u, int) const { if (u.pn == 3 || u.pn == 4) wait_v<6>(); else wait_v<6 + 8>(); }
    template <int AI>
    __device__ __forceinline__ void half(const f32x4 (&acc)[2][2][4][2], const Unit& u, int wr, int wc, int fr_, int fq_, const PG8_LAS unsigned char* ss) const {
        int fr = fr_, fq = fq_; asm volatile("" : "+v"(fr), "+v"(fq));
        const int row0 = u.pm * BM + wr * 64 + fr;
        if (u.pn == 3 || u.pn == 4) {
          if constexpr (AI == 1) {
            const int head = 4 * (u.pn - 3) + wc;
            float rsv[8]; rs8_lds(ss, wr * 64 + fr, 1.0f / 128.0f, rsv);
            f32x4 gk[2][2];
#pragma unroll
            for (int bj = 0; bj < 2; ++bj) { gk[bj][0] = *(const f32x4*)(kn + 32 * bj + 8 * fq); gk[bj][1] = *(const f32x4*)(kn + 32 * bj + 8 * fq + 4); }
            const f32x4 gr1 = *(const f32x4*)(kn + 64 + 4 * fq), gr2 = *(const f32x4*)(kn + 80 + 4 * fq);
#pragma unroll
            for (int aim = 0; aim < 4; ++aim) { const int ai = aim >> 1;
                float kr[4]; u32x2 k1[4], k2[4]; f32x4 cs[4], sn[4];
#pragma unroll
                for (int m = (aim & 1) * 2; m < (aim & 1) * 2 + 2; ++m) { const int row = row0 + ai * HALF + m * 16;
                    kr[m] = ssq_kr[row];
                    k1[m] = *(const u32x2*)(PROJ0 + (size_t)row * 2048 + 1920 + 4 * fq); k2[m] = *(const u32x2*)(PROJ0 + (size_t)row * 2048 + 1936 + 4 * fq);
                    cs[m] = *(const f32x4*)(RT + (size_t)row * 32 + 4 * fq); sn[m] = *(const f32x4*)(RT + (size_t)row * 32 + 16 + 4 * fq); }
#pragma unroll
                for (int m = (aim & 1) * 2; m < (aim & 1) * 2 + 2; ++m) {
                    const int row = row0 + ai * HALF + m * 16; const float rs = rsv[ai * 4 + m];
                    float ss = (dot4(acc[ai][0][m][0]) + dot4(acc[ai][0][m][1])) + (dot4(acc[ai][1][m][0]) + dot4(acc[ai][1][m][1]));
                    ss = quad_sum(ss);
                    const float hr = __builtin_amdgcn_rsqf((ss * rs * rs + kr[m]) * (1.0f / 96.0f) + 1e-6f), f = hr * rs;
                    bf16_t* kd = KM + ((size_t)((row >> 12) * 8 + head) * 64 + ((row & 4095) >> 6)) * 6144 + (size_t)(row & 63) * 8;
#pragma unroll
                    for (int bj = 0; bj < 2; ++bj) st16(kd + (size_t)(4 * bj + fq) * 512, pack8(acc[ai][bj][m][0] * (gk[bj][0] * f), acc[ai][bj][m][1] * (gk[bj][1] * f)));
                    const f32x4 g1 = gr1 * hr, g2 = gr2 * hr; const u32x2 a1 = k1[m], a2 = k2[m];
                    const f32x4 r1 = (f32x4){__builtin_bit_cast(float, a1.x << 16), __builtin_bit_cast(float, a1.x & 0xffff0000u), __builtin_bit_cast(float, a1.y << 16), __builtin_bit_cast(float, a1.y & 0xffff0000u)} * g1;
                    const f32x4 r2 = (f32x4){__builtin_bit_cast(float, a2.x << 16), __builtin_bit_cast(float, a2.x & 0xffff0000u), __builtin_bit_cast(float, a2.y << 16), __builtin_bit_cast(float, a2.y & 0xffff0000u)} * g2;
                    const f32x4 o1 = r1 * cs[m] - r2 * sn[m], o2 = r2 * cs[m] + r1 * sn[m];
                    u32x2 w1, w2; w1.x = cvt_pk_bf16(o1[0], o1[1]); w1.y = cvt_pk_bf16(o1[2], o1[3]); w2.x = cvt_pk_bf16(o2[0], o2[1]); w2.y = cvt_pk_bf16(o2[2], o2[3]);
                    st8(kd + (size_t)(8 + (fq >> 1)) * 512 + (fq & 1) * 4, w1); st8(kd + (size_t)(10 + (fq >> 1)) * 512 + (fq & 1) * 4, w2);
                }
            }
          }
        } else {
            constexpr int ai = AI;
            const bool isq = u.pn < 3; const int colt = isq ? u.pn * 256 : (u.pn - 5) * 256;
            const int col0 = colt + wc * 32 + 8 * fq;
            float rsv[4]; rs4_lds(ss, ai * HALF + wr * 64 + fr, isq ? 1.0f / 256.0f : 1.0f / 128.0f, rsv);
#pragma unroll
                for (int m = 0; m < 4; ++m) {
                    const int row = row0 + ai * HALF + m * 16; const float rs = rsv[m];
#pragma unroll
                    for (int bj = 0; bj < 2; ++bj) { const int c = col0 + bj * HALF;
                        st16(isq ? Q + (size_t)row * 768 + c : V + vimg_off((row >> 12) * 8 + (c >> 6), row & 4095, c & 63), pack8(acc[ai][bj][m][0] * rs, acc[ai][bj][m][1] * rs)); }
                }
        }
    }
};
template <bool BASE_BF16, bool FINAL>
struct EpiRes {
    static constexpr bool PERM = true, AFTER_DRAIN = true, SSQ_LDS = false, SPLIT = false;
    static constexpr int S0 = 0, S1 = 0;
    const void* base; float* out; bf16_t* XB; float* ssq;
    __device__ __forceinline__ void preload(u32x4 (&braw)[2][4][2], const Unit& u, int wr, int wc) const {
        static_assert(BASE_BF16, "the residual base is the bf16 stream");
        int t = threadIdx.x; asm volatile("" : "+v"(t)); const int fr = t & 15, fq = (t >> 4) & 3;
        const int row0 = u.pm * BM + wr * 64 + fr, col0 = u.pn * BM + wc * 32 + 8 * fq;
#pragma unroll
        for (int ai = 0; ai < 2; ++ai)
#pragma unroll
            for (int m = 0; m < 4; ++m) { const size_t off = (size_t)(row0 + ai * HALF + m * 16) * 1024 + col0;
#pragma unroll
                for (int bj = 0; bj < 2; ++bj) braw[ai][m][bj] = *(const u32x4*)((const bf16_t*)base + off + bj * HALF); }
    }
    __device__ __forceinline__ void unpack(f32x4 (&acc)[2][2][4][2], const u32x4 (&braw)[2][4][2]) const {
#pragma unroll
        for (int ai = 0; ai < 2; ++ai)
#pragma unroll
            for (int m = 0; m < 4; ++m)
#pragma unroll
                for (int bj = 0; bj < 2; ++bj) { const u32x4 w = braw[ai][m][bj];
                    acc[ai][bj][m][0] = (f32x4){__builtin_bit_cast(float, w.x << 16), __builtin_bit_cast(float, w.x & 0xffff0000u), __builtin_bit_cast(float, w.y << 16), __builtin_bit_cast(float, w.y & 0xffff0000u)};
                    acc[ai][bj][m][1] = (f32x4){__builtin_bit_cast(float, w.z << 16), __builtin_bit_cast(float, w.z & 0xffff0000u), __builtin_bit_cast(float, w.w << 16), __builtin_bit_cast(float, w.w & 0xffff0000u)}; }
    }
    __device__ __forceinline__ void fused(const f32x4 (&acc)[2][2][4][2], const Unit& u, int wr, int wc, int fr_, int fq_, PG8_LAS unsigned char* lds, int tid) const {
        int fr = fr_, fq = fq_; asm volatile("" : "+v"(fr), "+v"(fq));
        const int row0 = u.pm * BM + wr * 64 + fr, col0 = u.pn * BM + wc * 32 + 8 * fq;
        PG8_LAS float* P = (PG8_LAS float*)lds;
#pragma unroll
        for (int ai = 0; ai < 2; ++ai) {
#pragma unroll
            for (int m = 0; m < 4; ++m) { const size_t off = (size_t)(row0 + ai * HALF + m * 16) * 1024 + col0; float p = 0.f;
#pragma unroll
                for (int bj = 0; bj < 2; ++bj) { const f32x4 x0 = acc[ai][bj][m][0], x1 = acc[ai][bj][m][1];
                    if (FINAL) { *(f32x4*)(out + off + bj * HALF) = x0; *(f32x4*)(out + off + bj * HALF + 4) = x1; }
                    else { p += dot4(x0) + dot4(x1); st16(XB + off + bj * HALF, pack8(x0, x1)); } }
                if (!FINAL) { p = quad_sum(p); if (fq == 0) P[(ai * HALF + wr * 64 + m * 16 + fr) * 4 + wc] = p; } }
        }
        if (!FINAL) {
            asm volatile("s_waitcnt lgkmcnt(0)" ::: "memory"); __builtin_amdgcn_s_barrier(); asm volatile("" ::: "memory");
            if (tid < 256) { const f32x4 q = *(const PG8_LAS f32x4*)(P + tid * 4); ssq[(size_t)(u.pm * BM + tid) * 4 + u.pn] = (q[0] + q[1]) + (q[2] + q[3]); }
        }
    }
};
struct EpiGU {
    static constexpr bool PERM = true, AFTER_DRAIN = false, SSQ_LDS = true, SPLIT = false;
    static constexpr int S0 = SPLIT ? 4 : 0, S1 = SPLIT ? 4 : 8;
    __device__ __forceinline__ const float* ssq_src(const Unit&) const { return ssqx; }
    bf16_t* H; const float* ssqx;
    __device__ __forceinline__ void init_lds(PG8_LAS unsigned char*, int) const {}
    __device__ __forceinline__ void wait_half0(const Unit&, int) const { wait_v<6 + 4>(); }
    template <int ai>
    __device__ __forceinline__ void half(const f32x4 (&acc)[2][2][4][2], const Unit& u, int wr, int wc, int fr_, int fq_, const PG8_LAS unsigned char* ss) const {
        if (ai == 1 && u.half != 0) return;
        int fr = fr_, fq = fq_; asm volatile("" : "+v"(fr), "+v"(fq));
        const int row0 = u.pm * BM + (u.half == 2 ? HALF : 0) + wr * 64 + fr, col0 = u.pn * 128 + wc * 32 + 8 * fq;
        float msv[4];
#pragma unroll
        for (int i = 0; i < 4; ++i) { const f32x4 a = *(const PG8_LAS f32x4*)(ss + (ai * HALF + wr * 64 + fr + i * 16) * 16); msv[i] = ((a[0] + a[1]) + (a[2] + a[3])) * (1.0f / 1024.0f) + 1e-6f; }
#pragma unroll
            for (int m = 0; m < 4; ++m) {
                const int row = row0 + ai * HALF + m * 16; const float ms = msv[m], cneg = -1.4426950408889634f * __builtin_amdgcn_rsqf(ms);
                f32x4 h[2];
#pragma unroll
                for (int n = 0; n < 2; ++n) { const f32x4 g = acc[ai][0][m][n], up = acc[ai][1][m][n]; const f32x4 a = g * cneg;
                    f32x4 t; t[0] = __builtin_amdgcn_exp2f(a[0]); t[1] = __builtin_amdgcn_exp2f(a[1]); t[2] = __builtin_amdgcn_exp2f(a[2]); t[3] = __builtin_amdgcn_exp2f(a[3]);
                    const f32x4 d = t * ms + ms;
                    f32x4 r; r[0] = __builtin_amdgcn_rcpf(d[0]); r[1] = __builtin_amdgcn_rcpf(d[1]); r[2] = __builtin_amdgcn_rcpf(d[2]); r[3] = __builtin_amdgcn_rcpf(d[3]);
                    h[n] = (g * up) * r; }
                __builtin_nontemporal_store(pack8(h[0], h[1]), (u32x4*)(H + (size_t)row * 2816 + col0));
            }
    }
};
struct EpiProj1 {
    static constexpr bool PERM = true, AFTER_DRAIN = false, SSQ_LDS = true, SPLIT = false;
    static constexpr int S0 = 0, S1 = 16;
    __device__ __forceinline__ const float* ssq_src(const Unit&) const { return ssqx; }
    bf16_t* Q; bf16_t* K; bf16_t* V; const float* ssqx; const float* qg; const float* kg; float qscale; const PG8_LAS unsigned char* gl;
    __device__ __forceinline__ void init_lds(PG8_LAS unsigned char* lds, int tid) const { if (tid < 128) ((PG8_LAS float*)(lds + GAIN_LDS_OFF))[tid] = tid < 64 ? qg[tid] * qscale : kg[tid - 64]; }
    __device__ __forceinline__ void wait_half0(const Unit&, int) const { wait_v<6 + 8>(); }
    template <int ai>
    __device__ __forceinline__ void half(const f32x4 (&acc)[2][2][4][2], const Unit& u, int wr, int wc, int fr_, int fq_, const PG8_LAS unsigned char* ss) const {
        int fr = fr_, fq = fq_; asm volatile("" : "+v"(fr), "+v"(fq));
        const int row0 = u.pm * BM + wr * 64 + fr;
        float rsv[4]; rs4_lds(ss, ai * HALF + wr * 64 + fr, 1.0f / 1024.0f, rsv);
        if (u.pn < 8) {
            const bool isq = u.pn < 4; bf16_t* dst = isq ? Q : K;
            const int head = 4 * (u.pn & 3) + wc, colh = head * 64 + 8 * fq;
            f32x4 gv[2][2];
#pragma unroll
            for (int bj = 0; bj < 2; ++bj)
#pragma unroll
                for (int n = 0; n < 2; ++n) gv[bj][n] = *(const PG8_LAS f32x4*)(gl + (isq ? 0 : 256) + (32 * bj + 8 * fq + 4 * n) * 4);
#pragma unroll
                for (int m = 0; m < 4; ++m) {
                    const int row = row0 + ai * HALF + m * 16; const float rs = rsv[m];
                    float ss2 = (dot4(acc[ai][0][m][0]) + dot4(acc[ai][0][m][1])) + (dot4(acc[ai][1][m][0]) + dot4(acc[ai][1][m][1]));
                    ss2 = quad_sum(ss2);
                    const float f = rs * __builtin_amdgcn_rsqf(ss2 * (rs * rs) * (1.0f / 64.0f) + 1e-6f);
                    const size_t kimg = ((size_t)((row >> 12) * 16 + head) * 64 + ((row & 4095) >> 6)) * 4096 + (size_t)(row & 63) * 8;
#pragma unroll
                    for (int bj = 0; bj < 2; ++bj) st16(isq ? dst + (size_t)row * 1024 + colh + 32 * bj : dst + kimg + (size_t)(4 * bj + fq) * 512, pack8(acc[ai][bj][m][0] * (gv[bj][0] * f), acc[ai][bj][m][1] * (gv[bj][1] * f)));
                }
        } else {
            const int col0 = (u.pn - 8) * 256 + wc * 32 + 8 * fq;
#pragma unroll
                for (int m = 0; m < 4; ++m) {
                    const int row = row0 + ai * HALF + m * 16; const float rs = rsv[m];
#pragma unroll
                    for (int bj = 0; bj < 2; ++bj) { const int c = col0 + bj * HALF, hd = c >> 6, d = c & 63;
                        st16(V + vimg_off((row >> 12) * 16 + hd, row & 4095, d), pack8(acc[ai][bj][m][0] * rs, acc[ai][bj][m][1] * rs)); }
                }
        }
    }
};

__device__ __forceinline__ void stage4(const void* b0, const void* b0q, const void* b1, const void* b1q, unsigned v0, unsigned d0, unsigned d1) {
    unsigned long long t0;
    asm volatile("s_mov_b32 m0, %6\n\ts_mov_b64 %0, %2\n\tglobal_load_lds_dwordx4 %1, %0\n\t"
                 "s_mov_b32 m0, %7\n\ts_nop 0\n\tglobal_load_lds_dwordx4 %1, %3\n\t"
                 "s_mov_b32 m0, %8\n\ts_nop 0\n\tglobal_load_lds_dwordx4 %1, %4\n\t"
                 "s_mov_b32 m0, %9\n\ts_nop 0\n\tglobal_load_lds_dwordx4 %1, %5"
                 : "=&s"(t0) : "v"(v0), "s"(b0), "s"(b0q), "s"(b1), "s"(b1q), "s"(d0), "s"(d0 + 8192u), "s"(d1), "s"(d1 + 8192u) : "memory");
}
__device__ __forceinline__ void stage1(const void* b0, unsigned v0, unsigned d0) {
    asm volatile("s_nop 4\n\ts_mov_b32 m0, %2\n\ts_nop 0\n\tglobal_load_lds_dwordx4 %0, %1" :: "v"(v0), "s"(b0), "s"(d0) : "memory");
}
template <class Epi, class Sched, bool ALIGN_EPI>
__device__ __forceinline__ void gemm_phase(PG8_LAS unsigned char* lds, const Gemm g, const Sched& S, const Epi& E) {
    const int tid = threadIdx.x, wid = __builtin_amdgcn_readfirstlane(tid >> 6), lane = tid & 63, wr = wid >> 2, wc = wid & 3, fr = lane & 15, fq = lane >> 4;
    const int K = g.K, ntf = K / BK, lda = g.lda;
#define PG8_NT(u) ((g.split_nt > 0 && (u).pn >= g.split_pn) ? g.split_nt : ntf)
    unsigned voffA, voffB;
    { int R, C; stage_rc(tid * 16, R, C); const int Rb = Epi::PERM ? ((R & ~31) + perm32(R & 31)) : R;
        voffA = (unsigned)(R * lda + C) * 2u; voffB = (unsigned)(Rb * K + C) * 2u; }
    const size_t qvoffA = (size_t)64 * lda * 2, qvoffB = (size_t)64 * K * 2;
    const size_t kstep = (size_t)(BK * 2);
    const size_t hstepA = (size_t)HALF * lda * 2, hstepB = (size_t)HALF * K * 2;
    const size_t tstepA = 2 * hstepA, tstepB = 2 * hstepB;
    const unsigned ldsw = (unsigned)wid * 1024u, ldsu = (unsigned)(size_t)lds;
    const int aoff = lds_byte(wr * 64 + fr, fq * 8), boff = lds_byte(wc * 32 + fr, fq * 8);
#define PG8_ABASE(u) ((const char*)g.A + ((u).pn >= g.split_pn ? (size_t)g.split_off * 2 : (size_t)0) + (size_t)(u).pm * tstepA + ((u).half == 2 ? hstepA : (size_t)0))
#define PG8_BBASE(u) ((const char*)g.Bt + (size_t)(u).pn * tstepB)
#define PG8_SA(b, h) (((b) * 2 + (h)) * HTB)
#define PG8_SB(b, h) ((4 + (b) * 2 + (h)) * HTB)
#define PG8_STAGE(bufoff, gbase, voff) do { _Pragma("unroll") for (int _i = 0; _i < 2; ++_i) \
        __builtin_amdgcn_global_load_lds((const unsigned*)((const char*)(gbase) + (voff)[_i]), (PG8_LAS unsigned*)(lds + (bufoff) + ldsw + _i * 8192), 16, 0, 0); } while (0)
#define PG8_STAGE2(buf0, base0, buf1, base1, voff) stage4((base0), (base0) + q##voff, (base1), (base1) + q##voff, (voff), ldsu + (buf0) + ldsw, ldsu + (buf1) + ldsw)
#define PG8_LDA(dst, b, h) do { _Pragma("unroll") for (int m = 0; m < 4; ++m) _Pragma("unroll") for (int k = 0; k < 2; ++k) dst[m][k] = *(const PG8_LAS bf16x8*)(lds + PG8_SA(b, h) + aoff + m * 2048 + k * 1024); } while (0)
#define PG8_LDB(dst, b, h) do { _Pragma("unroll") for (int n = 0; n < 2; ++n) _Pragma("unroll") for (int k = 0; k < 2; ++k) dst[n][k] = *(const PG8_LAS bf16x8*)(lds + PG8_SB(b, h) + boff + n * 2048 + k * 1024); } while (0)
#define PG8_MMA(ai, bj, At, Bt, Z) do { __builtin_amdgcn_s_setprio(1); _Pragma("unroll") for (int m = 0; m < 4; ++m) _Pragma("unroll") for (int n = 0; n < 2; ++n) { \
        f32x4 c_; if constexpr (Z) c_ = (f32x4){0.f, 0.f, 0.f, 0.f}; else c_ = acc[ai][bj][m][n];     \
        c_ = __builtin_amdgcn_mfma_f32_16x16x32_bf16(Bt[n][0], At[m][0], c_, 0, 0, 0); acc[ai][bj][m][n] = __builtin_amdgcn_mfma_f32_16x16x32_bf16(Bt[n][1], At[m][1], c_, 0, 0, 0); } \
        __builtin_amdgcn_s_setprio(0); } while (0)
#define PG8_WAIT_V(n) asm volatile("s_waitcnt vmcnt(" #n ")" ::: "memory")
#define PG8_WAIT_L(n) asm volatile("s_waitcnt lgkmcnt(" #n ")" ::: "memory")
#define PG8_BAR __builtin_amdgcn_s_barrier()
#define PG8_SCHED __builtin_amdgcn_sched_barrier(0)
    Unit cur, nxt; int ui = 0;
    if (!S.next(0, cur)) return;
    if constexpr (!Epi::AFTER_DRAIN) E.init_lds(lds, tid);
    f32x4 acc[2][2][4][2];
    bf16x8 At[4][2], B0[2][2], B1[2][2];
    u32x4 braw[Epi::AFTER_DRAIN ? 2 : 1][4][2];
    if constexpr (Epi::AFTER_DRAIN) E.preload(braw, cur, wr, wc);
    const char* cA = PG8_ABASE(cur); const char* cB = PG8_BBASE(cur);
    PG8_STAGE2(PG8_SB(0, 0), cB, PG8_SB(0, 1), cB + hstepB, voffB); PG8_STAGE2(PG8_SA(0, 0), cA, PG8_SA(0, 1), cA + hstepA, voffA);
    if (wr == 1) PG8_BAR;
    PG8_WAIT_V(2); PG8_BAR;
    if constexpr (Epi::AFTER_DRAIN) E.unpack(acc, braw);
    PG8_STAGE2(PG8_SB(1, 0), cB + kstep, PG8_SB(1, 1), cB + hstepB + kstep, voffB);
    PG8_WAIT_V(4); PG8_BAR;
#define PG8_ITER(FA, ZF, t) do { \
            const bool last = ((t) == nt - 2); \
            const char* a1 = cA + (size_t)((t) + 1) * kstep; \
            const char* a2 = last ? nA : cA + (size_t)((t) + 2) * kstep; const char* b2 = last ? nB : cB + (size_t)((t) + 2) * kstep; \
            const char* b3 = b2 + kstep; \
            PG8_LDB(B0, 0, 0); PG8_LDB(B1, 0, 1); PG8_SCHED; PG8_LDA(At, 0, 0); \
            if constexpr (FA) { wait_v<8 + 1 + Epi::S0 + Epi::S1>(); } else { PG8_STAGE2(PG8_SA(1, 0), a1, PG8_SA(1, 1), a1 + hstepA, voffA); PG8_WAIT_V(8); } \
            PG8_WAIT_L(4); PG8_BAR;     \
            PG8_MMA(0, 0, At, B0, ZF); PG8_MMA(0, 1, At, B1, ZF); PG8_BAR; PG8_SCHED; \
            PG8_LDA(At, 0, 1); PG8_STAGE2(PG8_SB(0, 0), b2, PG8_SB(0, 1), b2 + hstepB, voffB); \
            if constexpr (FA) { wait_v<6 + 1 + Epi::S1>(); } else PG8_WAIT_V(6); \
            PG8_WAIT_L(0); PG8_BAR; if (cur.half == 0) { PG8_MMA(1, 0, At, B0, ZF); PG8_MMA(1, 1, At, B1, ZF); } PG8_BAR; PG8_SCHED; \
            PG8_LDB(B0, 1, 0); PG8_LDB(B1, 1, 1); PG8_SCHED; PG8_LDA(At, 1, 0); PG8_STAGE2(PG8_SA(0, 0), a2, PG8_SA(0, 1), a2 + hstepA, voffA); \
            if constexpr (FA) { wait_v<8 + 1 + Epi::S1>(); } else PG8_WAIT_V(8); \
            PG8_WAIT_L(4); PG8_BAR; PG8_MMA(0, 0, At, B0, false); PG8_MMA(0, 1, At, B1, false); PG8_BAR; PG8_SCHED; \
            PG8_LDA(At, 1, 1); PG8_STAGE2(PG8_SB(1, 0), b3, PG8_SB(1, 1), b3 + hstepB, voffB); \
            if constexpr (Epi::SPLIT) { \
                  \
                if (last) { E.template half<0>(acc, cur, wr, wc, fr, fq, lds + SSQ_LDS_OFF + (ui & 1) * SSQ_LDS_BYTES); E.wait_half0(cur, wc); } else PG8_WAIT_V(6); \
            } else PG8_WAIT_V(6); \
            PG8_WAIT_L(0); PG8_BAR; if (cur.half == 0) { PG8_MMA(1, 0, At, B0, false); PG8_MMA(1, 1, At, B1, false); } PG8_BAR; PG8_SCHED; \
        } while (0)
#define PG8_SSQ_DMA() do { if constexpr (Epi::SSQ_LDS) {     \
            const char* sb = (const char*)(E.ssq_src(cur) + (size_t)(cur.pm * BM + (cur.half == 2 ? HALF : 0) + wc * 64) * 4); \
            unsigned l16 = threadIdx.x; asm volatile("" : "+v"(l16)); l16 = (l16 & 63u) * 16u;     \
            stage1(sb, l16, ldsu + SSQ_LDS_OFF + (ui & 1) * SSQ_LDS_BYTES + wc * 1024); } } while (0)
    int nt = PG8_NT(cur);
    constexpr bool PRE = !Epi::AFTER_DRAIN;
    bool has_next = Epi::AFTER_DRAIN ? false : S.next(1, nxt);
    const char* nA = has_next ? PG8_ABASE(nxt) : cA; const char* nB = has_next ? PG8_BBASE(nxt) : cB;
    PG8_SSQ_DMA();
    if constexpr (Epi::AFTER_DRAIN) PG8_ITER(false, false, 0); else PG8_ITER(false, true, 0);
    for (;;) {
        for (int t = 2; t < nt; t += 2) PG8_ITER(false, false, t);
        if constexpr (PRE) { if (has_next) { PG8_STAGE2(PG8_SA(1, 0), nA + kstep, PG8_SA(1, 1), nA + kstep + hstepA, voffA); } }
        if constexpr (ALIGN_EPI) { if (wr == 0) PG8_BAR; }
        if constexpr (!Epi::AFTER_DRAIN) { if constexpr (!Epi::SPLIT) E.template half<0>(acc, cur, wr, wc, fr, fq, lds + SSQ_LDS_OFF + (ui & 1) * SSQ_LDS_BYTES);
                                           E.template half<1>(acc, cur, wr, wc, fr, fq, lds + SSQ_LDS_OFF + (ui & 1) * SSQ_LDS_BYTES); }
        if (!has_next) break;
        cur = nxt; cA = nA; cB = nB; ++ui; nt = PG8_NT(cur);
        if constexpr (ALIGN_EPI) { if (wr == 1) PG8_BAR; }
        has_next = Epi::AFTER_DRAIN ? false : S.next(ui + 1, nxt);
        nA = has_next ? PG8_ABASE(nxt) : cA; nB = has_next ? PG8_BBASE(nxt) : cB;
        PG8_SSQ_DMA();
        if constexpr (PRE) PG8_ITER(true, true, 0); else PG8_ITER(false, true, 0);
    }
#undef PG8_ITER
#undef PG8_SSQ_DMA
    PG8_WAIT_V(0);
    if constexpr (!ALIGN_EPI) { if (wr == 0) PG8_BAR; }
    PG8_BAR;
    if constexpr (Epi::AFTER_DRAIN) E.fused(acc, cur, wr, wc, fr, fq, lds, tid);
#undef PG8_ABASE
#undef PG8_NT
#undef PG8_BBASE
#undef PG8_SA
#undef PG8_SB
#undef PG8_STAGE
#undef PG8_STAGE2
#undef PG8_LDA
#undef PG8_LDB
#undef PG8_MMA
#undef PG8_WAIT_V
#undef PG8_WAIT_L
#undef PG8_BAR
#undef PG8_SCHED
}
}

constexpr int NWAVES = 8;
constexpr int NB = 4, SEQ = 4096, T = NB * SEQ, D = 1024, FF = 2816;
constexpr float LOG2E = 1.4426950408889634f;
constexpr float C2_MLA = 0.10206207261596575f * LOG2E;
constexpr float C2_64 = 0.125f * LOG2E;
constexpr int NPHASE = 14;
constexpr int N_LAUNCHES = MK_N_LAUNCHES;

constexpr size_t MiB = 1u << 20;
#if defined(PROBE_PHASE)
constexpr size_t WS_CTL = 0, CTL_ZERO_BYTES = 1 * MiB;
#else
constexpr size_t WS_CTL = 0, CTL_ZERO_BYTES = 64 * 1024;
#endif
constexpr size_t WS_W0IN = 1 * MiB, WS_UP0 = 5 * MiB, WS_WO0 = 6 * MiB, WS_GU0 = 8 * MiB, WS_WD0 = 19 * MiB;
constexpr size_t WS_W1IN = 25 * MiB, WS_WO1 = 31 * MiB, WS_GU1 = 33 * MiB, WS_WD1 = 44 * MiB, WS_WF = 50 * MiB;
constexpr size_t WS_SSQX = 51 * MiB, WS_SSQC = 52 * MiB, WS_SSQKV = 52 * MiB + 512 * 1024, WS_LOGF = 53 * MiB, WS_DEC = 54 * MiB;
constexpr size_t WS_XB = 56 * MiB, WS_O = 88 * MiB, WS_R = 120 * MiB, WS_ROPE = 216 * MiB, WS_QAUG = 218 * MiB, WS_KAUG = 226 * MiB, WS_SBK = WS_R + 64 * MiB, WS_SBV = WS_R + 80 * MiB, WS_END = 234 * MiB;
constexpr size_t R_PROJ0 = WS_R, R_KNOPE = WS_R + 64 * MiB, R_H = WS_R, R_Q1 = WS_R, R_K1 = WS_R + 32 * MiB, R_V1 = WS_R + 64 * MiB;
constexpr size_t DO_QM = 0, DO_KM = 24 * MiB, DO_VM = 48 * MiB;
#if defined(PROBE_PHASE)
constexpr int CW_BAR = 4096, CW_Q10 = 32768;
#else
constexpr int CW_BAR = 4096, CW_Q10 = 12288;
#endif
constexpr int CW_LOGF = CW_Q10 + 64;

constexpr int RING_OFF = 0, RING_BYTES = 131072;
constexpr int LDSCTL_OFF = RING_BYTES, MISC_OFF = LDSCTL_OFF + 320;
constexpr int LDS_BYTES = 147456;

#define GAS __attribute__((address_space(1)))
#define LAS __attribute__((address_space(3)))
typedef unsigned short bf16;
typedef unsigned v4u __attribute__((ext_vector_type(4)));
typedef float f32x4 __attribute__((ext_vector_type(4)));
typedef GAS unsigned gu32;
#define RLX_AGENT __ATOMIC_RELAXED, __HIP_MEMORY_SCOPE_AGENT
#define LDS_WAIT() asm volatile("s_waitcnt lgkmcnt(0)" ::: "memory")
__device__ __forceinline__ unsigned f2bf(float f) { unsigned u = __builtin_bit_cast(unsigned, f); return (u + 0x7fffu + ((u >> 16) & 1u)) >> 16; }
__device__ __forceinline__ unsigned pk2(float lo, float hi) { return f2bf(lo) | (f2bf(hi) << 16); }
__device__ __forceinline__ float bflo(unsigned w) { return __builtin_bit_cast(float, w << 16); }
__device__ __forceinline__ float bfhi(unsigned w) { return __builtin_bit_cast(float, w & 0xffff0000u); }


namespace att {
using bf16x8 = __attribute__((ext_vector_type(8))) short;
using s16x4 = __attribute__((ext_vector_type(4))) short;
using f32x16 = __attribute__((ext_vector_type(16))) float;
using u32x4 = __attribute__((ext_vector_type(4))) unsigned;
typedef unsigned short bf16;
constexpr int NW = 8, QBLK = 32, QB = 256, KVBLK = 64, NSLOT = 3, VSLOTB = 8192;
#define SBAR() __builtin_amdgcn_sched_barrier(0)
__device__ __forceinline__ int crow(int r, int hi) { return (r & 3) + 8 * (r >> 2) + 4 * hi; }
template <bool STRICT> __device__ __forceinline__ void cmask(f32x16& p0, f32x16& p1, int jb, int qrel, int hi) {
    const float NEG = -INFINITY; const int kb = 64 * jb + 4 * hi + (STRICT ? 1 : 0);
#pragma unroll
    for (int r = 0; r < 16; ++r) { const int kv = kb + (r & 3) + 8 * (r >> 2); if (kv > qrel) p0[r] = NEG; if (kv + 32 > qrel) p1[r] = NEG; }
}
__device__ __forceinline__ void glds16(const void* sbase, unsigned voff, unsigned lds_dst) { unsigned long long t;
    asm volatile("s_mov_b32 m0, %3\n\ts_mov_b64 %0, %2\n\tglobal_load_lds_dwordx4 %1, %0" : "=&s"(t) : "v"(voff), "s"(sbase), "s"(lds_dst) : "memory"); }
__device__ __forceinline__ const char* uni_ptr(const void* p) { const unsigned long long v = (unsigned long long)p; const unsigned lo = __builtin_amdgcn_readfirstlane((unsigned)v), hi = __builtin_amdgcn_readfirstlane((unsigned)(v >> 32));
    return (const char*)(((unsigned long long)hi << 32) | lo); }
typedef float f32x2_t __attribute__((ext_vector_type(2))); typedef __bf16 bf16x2_t __attribute__((ext_vector_type(2)));
__device__ __forceinline__ unsigned cvtpk_s(float lo, float hi) { f32x2_t v = {lo, hi}; bf16x2_t b = __builtin_convertvector(v, bf16x2_t); return __builtin_bit_cast(unsigned, b); }
#define WAIT_BAR(N) asm volatile("s_waitcnt vmcnt(" #N ") lgkmcnt(0)\n\ts_barrier" ::: "memory")
typedef __attribute__((address_space(3))) const char* lds_cptr;
typedef short v4i16_t __attribute__((ext_vector_type(4)));
__device__ __forceinline__ void kload2(bf16x8* kf, lds_cptr kp, int j) { kf[2 * j] = *(const __attribute__((address_space(3))) bf16x8*)(kp + j * 2048); kf[2 * j + 1] = *(const __attribute__((address_space(3))) bf16x8*)(kp + j * 2048 + 512); }
__device__ __forceinline__ s16x4 vtr(lds_cptr p) { return __builtin_bit_cast(s16x4, __builtin_amdgcn_ds_read_tr16_b64_v4i16((__attribute__((address_space(3))) v4i16_t*)p)); }
#define MF32(a, b, c) __builtin_amdgcn_mfma_f32_32x32x16_bf16(a, b, c, 0, 0, 0)
__device__ __forceinline__ void pv(f32x16* o, int vb, bf16x8 pa0, bf16x8 pa1, bf16x8 pa2, bf16x8 pa3) {
#pragma unroll
    for (int d0 = 0; d0 < 2; ++d0) { s16x4 lo[4], hi[4];
#pragma unroll
        for (int ks = 0; ks < 4; ++ks) {
            asm volatile("ds_read_b64_tr_b16 %0,%1 offset:%c2" : "=&v"(lo[ks]) : "v"(vb), "i"(d0 * 4096 + ks * 1024) : "memory");
            asm volatile("ds_read_b64_tr_b16 %0,%1 offset:%c2" : "=&v"(hi[ks]) : "v"(vb), "i"(d0 * 4096 + ks * 1024 + 512) : "memory"); }
        asm volatile("s_waitcnt lgkmcnt(0)" ::: "memory"); SBAR();
#define PK(k) (bf16x8){lo[k][0], lo[k][1], lo[k][2], lo[k][3], hi[k][0], hi[k][1], hi[k][2], hi[k][3]}
        o[d0] = MF32(pa0, PK(0), o[d0]); o[d0] = MF32(pa1, PK(1), o[d0]); o[d0] = MF32(pa2, PK(2), o[d0]); o[d0] = MF32(pa3, PK(3), o[d0]);
#undef PK
    }
}

__device__ __forceinline__ void sb_task(const bf16* Qp, const bf16* Kp, const bf16* Vp, bf16* Op, int qs, char* wlds) {
    int tid = threadIdx.x; asm volatile("" : "+v"(tid));
    const int lane = tid & 63, r32 = lane & 31, hi = lane >> 5;
    bf16x8 qr[4];
#pragma unroll
    for (int j = 0; j < 4; ++j) qr[j] = *reinterpret_cast<const bf16x8*>(Qp + (size_t)(qs + r32) * 2048 + 16 * j + 8 * hi);
    f32x16 o[2]; o[0] = f32x16{}; o[1] = f32x16{};
    float Pc = 1.0f;
    const unsigned ldsb = (unsigned)__builtin_amdgcn_readfirstlane((unsigned)(uintptr_t)wlds);
    const int vb = (int)ldsb + ((lane >> 4) & 1) * 32 + (lane & 3) * 8 + (4 * hi + ((lane & 15) >> 2)) * 64;
    const char* vbase = uni_ptr(Vp);
    for (int k0 = qs; k0 >= 0; k0 -= 32) {
        const int tk = k0 >> 6, half = (k0 >> 5) & 1;
        if (k0 == qs || half == 1) {
#pragma unroll
            for (int w = 0; w < 8; ++w) glds16(vbase + (size_t)tk * 8192 + w * 1024, (unsigned)lane * 16u, ldsb + w * 1024);
        }
        bf16x8 kf[4];
#pragma unroll
        for (int j = 0; j < 4; ++j) kf[j] = *reinterpret_cast<const bf16x8*>(Kp + (size_t)tk * 4096 + (size_t)(2 * j + hi) * 512 + (half * 32 + r32) * 8);
        f32x16 C = f32x16{};
#pragma unroll
        for (int j = 0; j < 4; ++j) C = MF32(kf[j], qr[j], C);
        if (k0 == qs) {
#pragma unroll
            for (int r = 0; r < 16; ++r) if (crow(r, hi) >= r32) C[r] = -INFINITY;
        }
        float gp[4];
#pragma unroll
        for (int g = 0; g < 4; ++g) {
            float rr[4], bb[4];
#pragma unroll
            for (int i = 0; i < 4; ++i) { const float e = __builtin_amdgcn_exp2f(fminf(C[4 * g + i], 115.0f)); rr[i] = __builtin_amdgcn_rcpf(1.0f + e); bb[i] = e * rr[i]; }
            const float s2 = rr[3], s1 = rr[3] * rr[2], s0 = s1 * rr[1]; gp[g] = s0 * rr[0];
            C[4 * g + 3] = bb[3]; C[4 * g + 2] = bb[2] * s2; C[4 * g + 1] = bb[1] * s1; C[4 * g] = bb[0] * s0;
        }
        float GP[8];
#pragma unroll
        for (int g = 0; g < 4; ++g) { auto sw = __builtin_amdgcn_permlane32_swap(__float_as_uint(gp[g]), __float_as_uint(gp[g]), false, false); GP[2 * g] = __uint_as_float(sw[0]); GP[2 * g + 1] = __uint_as_float(sw[1]); }
        float GS[8]; float gs = Pc;
#pragma unroll
        for (int G = 7; G >= 0; --G) { GS[G] = gs; gs *= GP[G]; }
        Pc = gs;
        { const unsigned sel = 0u - (unsigned)hi;
#pragma unroll
          for (int g = 0; g < 4; ++g) { const float m0 = __uint_as_float((__float_as_uint(GS[2 * g]) & ~sel) | (__float_as_uint(GS[2 * g + 1]) & sel));
#pragma unroll
              for (int i = 0; i < 4; ++i) C[4 * g + i] *= m0; } }
        const u32x4 pw0 = (u32x4){cvtpk_s(C[0], C[1]), cvtpk_s(C[2], C[3]), cvtpk_s(C[4], C[5]), cvtpk_s(C[6], C[7])};
        const u32x4 pw1 = (u32x4){cvtpk_s(C[8], C[9]), cvtpk_s(C[10], C[11]), cvtpk_s(C[12], C[13]), cvtpk_s(C[14], C[15])};
        asm volatile("s_waitcnt vmcnt(0)" ::: "memory"); SBAR();
        { const int vbh = vb + half * 2048;
#pragma unroll
          for (int d0 = 0; d0 < 2; ++d0) { s16x4 lo[2], hh[2];
#pragma unroll
              for (int ks = 0; ks < 2; ++ks) {
                  asm volatile("ds_read_b64_tr_b16 %0,%1 offset:%c2" : "=&v"(lo[ks]) : "v"(vbh), "i"(d0 * 4096 + ks * 1024) : "memory");
                  asm volatile("ds_read_b64_tr_b16 %0,%1 offset:%c2" : "=&v"(hh[ks]) : "v"(vbh), "i"(d0 * 4096 + ks * 1024 + 512) : "memory"); }
              asm volatile("s_waitcnt lgkmcnt(0)" ::: "memory"); SBAR();
              o[d0] = MF32(__builtin_bit_cast(bf16x8, pw0), ((bf16x8){lo[0][0], lo[0][1], lo[0][2], lo[0][3], hh[0][0], hh[0][1], hh[0][2], hh[0][3]}), o[d0]);
              o[d0] = MF32(__builtin_bit_cast(bf16x8, pw1), ((bf16x8){lo[1][0], lo[1][1], lo[1][2], lo[1][3], hh[1][0], hh[1][1], hh[1][2], hh[1][3]}), o[d0]); } }
        if (__all(Pc < 0x1p-134f)) break;
    }
    asm volatile("s_waitcnt vmcnt(0)" ::: "memory");
#pragma unroll
    for (int r = 0; r < 16; ++r)
#pragma unroll
        for (int d0 = 0; d0 < 2; ++d0) Op[(size_t)(qs + crow(r, hi)) * 1024 + 32 * d0 + r32] = (bf16)f2bf(o[d0][r]);
}
struct AttnArgs { const bf16* Q; const bf16* K; const bf16* V; bf16* O; const bf16* QA; const bf16* KA; int ldq, ldk, ldv, ldo, lda; float mref; const float* RT; const float* qn; unsigned* qhead; volatile LAS unsigned* tick; };
template <int KS, bool FOX = false> struct Lay { static constexpr int KSLOTB = FOX ? (2 * KS - 1) * 1024 : KS * 2048, LDS_K = 0, LDS_V = NSLOT * KSLOTB, LDS_WS = LDS_V + NSLOT * VSLOTB, LDS_OST = LDS_WS + NW * 256, LDS_BYTES = LDS_OST + NW * 4096; };

template <int KS, bool FOX, bool NOSUB = false>
__device__ __forceinline__ void attn_unit(const AttnArgs& A, int qb, int tbeg, char* shm) {
    typedef Lay<KS, FOX> L;
    constexpr int KSLOTB = L::KSLOTB, LDS_K = L::LDS_K, LDS_V = L::LDS_V, LDS_WS = L::LDS_WS, LDS_OST = L::LDS_OST, NX = FOX ? 1 : 2 * KS - 8;
    int tid = threadIdx.x; asm volatile("" : "+v"(tid));
    const int lane = tid & 63, r32 = lane & 31, hi = lane >> 5; const int wid = __builtin_amdgcn_readfirstlane(tid >> 6);
    const int q0 = qb * QB;
    const unsigned lds0 = (unsigned)(uintptr_t)shm;
    float* wsf = (float*)(shm + LDS_WS) + wid * 64;
    const bool xk = (NX > 0) && (wid < NX);
    constexpr long KTILEB = (FOX ? 8 : 2 * KS) * 1024;
    const char* kbase = uni_ptr(A.K) + (long)tbeg * KTILEB + wid * 1024; const char* kbase2 = FOX ? uni_ptr(A.KA) + (long)tbeg * KVBLK * A.lda * 2 : kbase + 8 * 1024;
    const char* vbase = uni_ptr(A.V) + (long)tbeg * 8192 + wid * 1024;
    const unsigned koff = (unsigned)lane * 16u;
    const unsigned koff2 = FOX ? (unsigned)(lane * A.lda + wid * 8) * 2u : koff;
    const unsigned voff = (unsigned)lane * 16u;
    const long kst = KTILEB, kst2 = FOX ? (long)KVBLK * A.lda * 2 : kst, vst = 8192;
    const unsigned kdst = lds0 + LDS_K + wid * 1024, kdst2 = lds0 + LDS_K + (8 + wid) * 1024, vdst = lds0 + LDS_V + wid * 1024;
#define DMA_K(t, s) do { glds16(kbase + (long)(t) * kst, koff, (unsigned)__builtin_amdgcn_readfirstlane(kdst + (s) * KSLOTB)); \
        if (xk) glds16(kbase2 + (long)(t) * kst2, koff2, (unsigned)__builtin_amdgcn_readfirstlane(kdst2 + (s) * KSLOTB)); } while (0)
#define DMA_V(t, s) glds16(vbase + (long)(t) * vst, voff, (unsigned)__builtin_amdgcn_readfirstlane(vdst + (s) * VSLOTB))
#define WAITB(Na, Nb) do { if (xk) { WAIT_BAR(Nb); } else { WAIT_BAR(Na); } } while (0)
    const int vb0 = (int)(lds0 + LDS_V) + ((lane >> 4) & 1) * 32 + (lane & 3) * 8 + (4 * hi + ((lane & 15) >> 2)) * 64;
    const lds_cptr shm3 = (lds_cptr)shm; const lds_cptr kp0 = shm3 + LDS_K + hi * 1024 + r32 * 16;
    const lds_cptr kpa = shm3 + LDS_K + 8192 + r32 * 16 - (KS - 1) * 2048;
    const lds_cptr vp0 = shm3 + LDS_V + ((lane >> 4) & 1) * 32 + (lane & 3) * 8 + (4 * hi + ((lane & 15) >> 2)) * 64;
    bf16x8 kf[2 * KS];
    const int NT = (q0 + QB) / KVBLK - tbeg;
    DMA_K(0, 0); DMA_V(0, 0); DMA_K(1, 1);
    bf16x8 qr[KS];
    { const bf16* Qw = A.Q + (long)(q0 + wid * QBLK + r32) * A.ldq;
#pragma unroll
      for (int d0 = 0; d0 < (FOX ? KS - 1 : KS); ++d0) qr[d0] = *reinterpret_cast<const bf16x8*>(Qw + d0 * 16 + hi * 8);
      if (FOX) { qr[KS - 1] = *reinterpret_cast<const bf16x8*>(A.QA + (long)(q0 + wid * QBLK + r32) * A.lda); if (hi) qr[KS - 1] = bf16x8{0, 0, 0, 0, 0, 0, 0, 0}; } }
    if constexpr (!FOX && KS == 6) {
        float qf[6][8]; float ss = 0.f;
#pragma unroll
        for (int j = 0; j < 6; ++j) { const u32x4 w = __builtin_bit_cast(u32x4, qr[j]);
            qf[j][0] = __builtin_bit_cast(float, w.x << 16); qf[j][1] = __builtin_bit_cast(float, w.x & 0xffff0000u); qf[j][2] = __builtin_bit_cast(float, w.y << 16); qf[j][3] = __builtin_bit_cast(float, w.y & 0xffff0000u);
            qf[j][4] = __builtin_bit_cast(float, w.z << 16); qf[j][5] = __builtin_bit_cast(float, w.z & 0xffff0000u); qf[j][6] = __builtin_bit_cast(float, w.w << 16); qf[j][7] = __builtin_bit_cast(float, w.w & 0xffff0000u);
#pragma unroll
            for (int e = 0; e < 8; ++e) ss += qf[j][e] * qf[j][e]; }
        { auto rr = __builtin_amdgcn_permlane32_swap(__float_as_uint(ss), __float_as_uint(ss), false, false); ss = __uint_as_float(rr[0]) + __uint_as_float(rr[1]); }
        const float rn = 0.14724445f * __builtin_amdgcn_rsqf(ss * (1.0f / 96.0f) + 1e-6f);
        const float* rt = A.RT + (size_t)(q0 + wid * QBLK + r32) * 32 + 8 * hi;
#pragma unroll
        for (int j = 0; j < 4; ++j)
#pragma unroll
            for (int e = 0; e < 8; ++e) qf[j][e] *= rn * A.qn[16 * j + 8 * hi + e];
#pragma unroll
        for (int e = 0; e < 8; ++e) { const float r1 = qf[4][e] * rn * A.qn[64 + 8 * hi + e], r2 = qf[5][e] * rn * A.qn[80 + 8 * hi + e], c = rt[e], sn = rt[16 + e];
            qf[4][e] = r1 * c - r2 * sn; qf[5][e] = r2 * c + r1 * sn; }
#pragma unroll
        for (int j = 0; j < 6; ++j) { const u32x4 w = (u32x4){cvtpk_s(qf[j][0], qf[j][1]), cvtpk_s(qf[j][2], qf[j][3]), cvtpk_s(qf[j][4], qf[j][5]), cvtpk_s(qf[j][6], qf[j][7])}; qr[j] = __builtin_bit_cast(bf16x8, w); }
    }
    const float mref = (FOX || NOSUB) ? 0.f : A.mref;
    float l_reg = 0.f; f32x16 o[2]; o[0] = f32x16{}; o[1] = f32x16{};
    const f32x16 zz = f32x16{};
    const int qrel = wid * QBLK + r32;
#define CMASK(P0, P1, t) do { int jb_ = (t) - (NT - 4); if (jb_ >= 0) cmask<false>(P0, P1, jb_, qrel, hi); } while (0)
#define EX(v) __builtin_amdgcn_exp2f((v) - mref)
    f32x16 pA0, pA1, pB0, pB1;
    int s_prev = 0, s_cur = 0, s_next = 1;
#define ROT() do { s_prev = s_cur; s_cur = s_next; s_next = (s_next == NSLOT - 1) ? 0 : s_next + 1; } while (0)
    DMA_K(2, 2);
    WAITB(3, 5);
    { const lds_cptr kb = kp0;
#pragma unroll
      for (int d0 = 0; d0 < KS; ++d0) {
          const lds_cptr kq = (FOX && d0 == KS - 1) ? kpa : kb;
          const bf16x8 b0 = *(const __attribute__((address_space(3))) bf16x8*)(kq + d0 * 2048), b1 = *(const __attribute__((address_space(3))) bf16x8*)(kq + d0 * 2048 + 512);
          if (d0 == 0) { pA0 = MF32(b0, qr[0], zz); pA1 = MF32(b1, qr[0], zz); } else { pA0 = MF32(b0, qr[d0], pA0); pA1 = MF32(b1, qr[d0], pA1); } } }
    CMASK(pA0, pA1, 0);
#pragma unroll
    for (int r = 0; r < 16; ++r) { pA0[r] = EX(pA0[r]); pA1[r] = EX(pA1[r]); }
    WAITB(0, 0);
    DMA_K(3, 0); DMA_V(1, 1);
    ROT();
#pragma unroll
    for (int j = 0; j < KS; ++j) kload2(kf, ((FOX && j == KS - 1) ? kpa : kp0) + s_cur * KSLOTB, j);
    WAITB(2, 3);
    s16x4 vlo[8], vhi[8]; u32x4 pw0, pw1, pw2, pw3;
#define PKW(P, B) cvtpk_s(P[B], P[B + 1])
#define PAF(k) __builtin_bit_cast(bf16x8, pw##k)
#define VFR(i) (bf16x8){vlo[i][0], vlo[i][1], vlo[i][2], vlo[i][3], vhi[i][0], vhi[i][1], vhi[i][2], vhi[i][3]}
#define PIN(x) asm volatile("" : "+v"(x))
#define GAPA(MF, A0, A1, A2, A3, W0, W1, PW) do { MF; sacc += A0; sacc += A1; sacc += A2; sacc += A3; PIN(sacc); W0; W1; PIN(PW); SBAR(); } while (0)
#define GAPB(MF, X, B) do { MF; X[B] = EX(X[B]); X[B + 1] = EX(X[B + 1]); X[B + 2] = EX(X[B + 2]); X[B + 3] = EX(X[B + 3]); PIN(X); SBAR(); } while (0)
#define VRD(i) do { vlo[i] = vtr(vp_ + (((i) >> 2) * 4096 + ((i) & 3) * 1024)); vhi[i] = vtr(vp_ + (((i) >> 2) * 4096 + ((i) & 3) * 1024 + 512)); } while (0)
#define KRD(G, j) do { if constexpr (KS > (j)) { if (G) { kload2(kf, ((FOX && (j) == KS - 1) ? kpa : kp0) + s_next * KSLOTB, j); SBAR(); } } } while (0)
#define XQK(C0, C1, j) do { if constexpr (KS > (j)) { C0 = MF32(kf[2 * (j)], qr[j], C0); C1 = MF32(kf[2 * (j) + 1], qr[j], C1); SBAR(); } } while (0)
#define STEP(C0, C1, P0, P1, t, GK, GV, GL) do { SBAR(); \
    const lds_cptr vp_ = vp0 + s_prev * VSLOTB; \
    VRD(0); SBAR(); float sacc = (P0[0] + P0[1]); \
    GAPA(C0 = MF32(kf[0], qr[0], zz), P0[2], P0[3], P0[4], P0[5],     pw0[0] = PKW(P0, 0), pw0[1] = PKW(P0, 2), pw0); \
    VRD(4); SBAR(); GAPA(C1 = MF32(kf[1], qr[0], zz), P0[6], P0[7], P0[8], P0[9],     pw0[2] = PKW(P0, 4), pw0[3] = PKW(P0, 6), pw0); \
    VRD(1); SBAR(); GAPA(C0 = MF32(kf[2], qr[1], C0),   P0[10], P0[11], P0[12], P0[13], pw1[0] = PKW(P0, 8), pw1[1] = PKW(P0, 10), pw1); \
    VRD(5); SBAR(); GAPA(C1 = MF32(kf[3], qr[1], C1),   P0[14], P0[15], P1[0], P1[1],   pw1[2] = PKW(P0, 12), pw1[3] = PKW(P0, 14), pw1); \
    VRD(2); SBAR(); GAPA(C0 = MF32(kf[4], qr[2], C0),   P1[2], P1[3], P1[4], P1[5],     pw2[0] = PKW(P1, 0), pw2[1] = PKW(P1, 2), pw2); \
    VRD(6); SBAR(); GAPA(C1 = MF32(kf[5], qr[2], C1),   P1[6], P1[7], P1[8], P1[9],     pw2[2] = PKW(P1, 4), pw2[3] = PKW(P1, 6), pw2); \
    VRD(3); SBAR(); GAPA(C0 = MF32(kf[6], qr[3], C0),   P1[10], P1[11], P1[12], P1[13], pw3[0] = PKW(P1, 8), pw3[1] = PKW(P1, 10), pw3); \
    VRD(7); SBAR(); GAPA(C1 = MF32(kf[7], qr[3], C1),   P1[14], P1[15], 0.f, 0.f,       pw3[2] = PKW(P1, 12), pw3[3] = PKW(P1, 14), pw3); \
    XQK(C0, C1, 4); XQK(C0, C1, 5); \
    l_reg += sacc; \
    if (GK) { DMA_K((t) + 3, s_cur); } if (GV) { DMA_V((t) + 1, s_next); } \
    CMASK(C0, C1, t); \
    SBAR(); \
    GAPB(o[0] = MF32(PAF(0), VFR(0), o[0]), C0, 0); \
    GAPB(o[1] = MF32(PAF(0), VFR(4), o[1]), C0, 4); \
    KRD(GL, 0); GAPB(o[0] = MF32(PAF(1), VFR(1), o[0]), C0, 8); \
    KRD(GL, 1); GAPB(o[1] = MF32(PAF(1), VFR(5), o[1]), C0, 12); \
    KRD(GL, 2); GAPB(o[0] = MF32(PAF(2), VFR(2), o[0]), C1, 0); \
    KRD(GL, 3); GAPB(o[1] = MF32(PAF(2), VFR(6), o[1]), C1, 4); \
    KRD(GL, 4); GAPB(o[0] = MF32(PAF(3), VFR(3), o[0]), C1, 8); \
    KRD(GL, 5); GAPB(o[1] = MF32(PAF(3), VFR(7), o[1]), C1, 12); \
    } while (0)
    int t = 1;
#undef CMASK
#define CMASK(P0, P1, t) do {} while (0)
    for (; t + 5 < NT; t += 2) {
        STEP(pB0, pB1, pA0, pA1, t, true, true, true);     WAITB(2, 3); ROT();
        STEP(pA0, pA1, pB0, pB1, t + 1, true, true, true); WAITB(2, 3); ROT();
    }
#undef CMASK
#define CMASK(P0, P1, t) do { int jb_ = (t) - (NT - 4); if (jb_ >= 0) cmask<false>(P0, P1, jb_, qrel, hi); } while (0)
#define ENDW(tt) do { if ((tt) + 3 < NT) { WAITB(2, 3); } else if ((tt) + 2 < NT) { WAITB(1, 1); } else { WAITB(0, 0); } } while (0)
    for (; t + 1 < NT; t += 2) {
        STEP(pB0, pB1, pA0, pA1, t, (t + 3 < NT), (t + 1 < NT), (t + 1 < NT));     ENDW(t);     ROT();
        STEP(pA0, pA1, pB0, pB1, t + 1, (t + 4 < NT), (t + 2 < NT), (t + 2 < NT)); ENDW(t + 1); ROT();
    }
    unsigned ntk_ = 0u;
    if constexpr (FOX) { if (threadIdx.x == 0) ntk_ = gridDim.x + __hip_atomic_fetch_add(A.qhead, 1u, __ATOMIC_RELAXED, __HIP_MEMORY_SCOPE_AGENT); }
    STEP(pB0, pB1, pA0, pA1, NT - 1, false, false, false);
    { float sacc = pB0[0] + pB0[1];
#pragma unroll
      for (int r = 2; r < 16; ++r) sacc += pB0[r];
#pragma unroll
      for (int r = 0; r < 16; ++r) sacc += pB1[r];
      l_reg += sacc;
      pw0 = (u32x4){PKW(pB0, 0), PKW(pB0, 2), PKW(pB0, 4), PKW(pB0, 6)}; pw1 = (u32x4){PKW(pB0, 8), PKW(pB0, 10), PKW(pB0, 12), PKW(pB0, 14)};
      pw2 = (u32x4){PKW(pB1, 0), PKW(pB1, 2), PKW(pB1, 4), PKW(pB1, 6)}; pw3 = (u32x4){PKW(pB1, 8), PKW(pB1, 10), PKW(pB1, 12), PKW(pB1, 14)};
      SBAR(); pv(o, vb0 + s_cur * VSLOTB, PAF(0), PAF(1), PAF(2), PAF(3)); }
#undef PKW
#undef PAF
#undef VFR
#undef PIN
#undef GAPA
#undef GAPB
#undef VRD
#undef KRD
#undef XQK
#undef STEP
#undef ENDW
    { auto rr = __builtin_amdgcn_permlane32_swap(__float_as_uint(l_reg), __float_as_uint(l_reg), false, false); l_reg = __uint_as_float(rr[0]) + __uint_as_float(rr[1]); }
    if (hi == 0) wsf[32 + r32] = l_reg; asm volatile("s_waitcnt lgkmcnt(0)" ::: "memory");
    float rli[16];
#pragma unroll
    for (int r = 0; r < 16; ++r) rli[r] = __builtin_amdgcn_rcpf(wsf[32 + crow(r, hi)]);
    bf16* Ow = A.O + (long)(q0 + wid * QBLK) * A.ldo;
    { bf16* stg = (bf16*)(shm + LDS_OST) + wid * 2048;
#pragma unroll
      for (int r = 0; r < 16; ++r) { const int orow = crow(r, hi);
#pragma unroll
          for (int d0 = 0; d0 < 2; ++d0) stg[orow * 64 + d0 * 32 + r32] = (bf16)f2bf(o[d0][r] * rli[r]); }
      asm volatile("s_waitcnt lgkmcnt(0)" ::: "memory");
#pragma unroll
      for (int i = 0; i < 4; ++i) { const int row = i * 8 + (lane >> 3), ch = lane & 7; const u32x4 v = *(const u32x4*)(stg + row * 64 + ch * 8); pg8::st16(Ow + (long)row * A.ldo + ch * 8, v); } }
    if constexpr (FOX) { if (threadIdx.x == 0) A.tick[0] = ntk_; }
    asm volatile("s_waitcnt lgkmcnt(0)\n\ts_barrier" ::: "memory");
#undef DMA_K
#undef DMA_V
#undef WAITB
#undef CMASK
#undef EX
#undef ROT
}
#undef SBAR
#undef WAIT_BAR
}

#define XB_TMO      128
#define XB_XCNT(j)  (256  + 64 * (j))
#define XB_XSUB(j)  (1280 + 64 * (j))
#define XB_XGEN(j)  (2304 + 64 * (j))
#define XB_TOP      3328
#define XB_TOPGEN   3392
#define XCD_BAR_WORDS 3456
#define XB_SPIN_CAP (1u << 18)
__device__ __forceinline__ unsigned xb_ld(unsigned* p)              { return __hip_atomic_load(p, __ATOMIC_RELAXED, __HIP_MEMORY_SCOPE_AGENT); }
__device__ __forceinline__ unsigned xb_add(unsigned* p, unsigned v) { return __hip_atomic_fetch_add(p, v, __ATOMIC_RELAXED, __HIP_MEMORY_SCOPE_AGENT); }
__device__ __forceinline__ unsigned xb_xcc_id() { return (unsigned)__builtin_amdgcn_s_getreg((3 << 11) | 20) & 0xFu; }
#define XB_SPIN(cond, bar) do { unsigned _sp = 0; while (cond) { __builtin_amdgcn_s_sleep(1); \
    if ((++_sp & 255u) == 0u) { if (xb_ld(&(bar)[XB_TMO])) break; if (_sp > XB_SPIN_CAP) { atomicAdd(&(bar)[XB_TMO], 1u); break; } } } } while (0)
struct XcdBarrier { unsigned* bar; unsigned x; volatile LAS unsigned* st; };
__device__ __forceinline__ XcdBarrier xcd_barrier_post(unsigned* bar, volatile LAS unsigned* st) {
    XcdBarrier b; b.bar = bar; b.x = xb_xcc_id(); b.st = st;
    if (threadIdx.x == 0) (void)xb_add(&bar[XB_XCNT(b.x)], 1u);
    return b;
}
__device__ __forceinline__ void xcd_barrier_complete(unsigned* bar, unsigned x, unsigned& nloc, unsigned& nx) {
    const unsigned G = gridDim.x * gridDim.y * gridDim.z;
    unsigned sum, cnt, mine, sp = 0u;
    for (;;) {
        sum = 0u; cnt = 0u; mine = 0u;
#pragma unroll
        for (unsigned j = 0; j < 16; ++j) { const unsigned c = xb_ld(&bar[XB_XCNT(j)]); sum += c; cnt += (c > 0u) ? 1u : 0u; mine = (j == x) ? c : mine; }
        if (sum == G) break;
        __builtin_amdgcn_s_sleep(1);
        if ((++sp & 255u) == 0u) { if (xb_ld(&bar[XB_TMO])) break; if (sp > XB_SPIN_CAP) { atomicAdd(&bar[XB_TMO], 1u); break; } }
    }
    nloc = mine > 0u ? mine : 1u; nx = cnt > 0u ? cnt : 1u;
}
__device__ __forceinline__ void xcd_barrier(const XcdBarrier& b) {
    asm volatile("s_waitcnt vmcnt(0)" ::: "memory");
    __syncthreads();
    if (threadIdx.x == 64) { __builtin_amdgcn_fence(__ATOMIC_ACQUIRE, "agent"); asm volatile("s_waitcnt vmcnt(0)" ::: "memory"); }
    if (threadIdx.x == 0) {
        unsigned* bar = b.bar;
        __builtin_amdgcn_s_waitcnt(0);
        unsigned nloc = b.st[0], nx = b.st[1];
        if (nloc == 0u) { xcd_barrier_complete(bar, b.x, nloc, nx); b.st[0] = nloc; b.st[1] = nx; }
        const unsigned k = b.st[3] + 1u; b.st[3] = k;
        const unsigned old = xb_add(&bar[XB_XSUB(b.x)], 1u);
        if (old + 1u == k * nloc) {
            __builtin_amdgcn_fence(__ATOMIC_RELEASE, "agent");
            asm volatile("s_waitcnt vmcnt(0)" ::: "memory");
            (void)xb_add(&bar[XB_TOP], 1u);
        }
        XB_SPIN(xb_ld(&bar[XB_TOP]) < k * nx, bar);
    }
    __syncthreads();
}

struct Args { const void* in[25]; float* out; unsigned char* ws; int ph_lo, ph_hi, li, pad; };
struct Frame {
    LAS unsigned char* lds; volatile LAS unsigned* MISC; gu32* ctl;
    int tid, lane, wave, vcu, G;
};
__device__ __forceinline__ float wave_sum(float v) {
#pragma unroll
    for (int o = 1; o < 64; o <<= 1) v += __shfl_xor(v, o);
    return v;
}

enum { MAT_W0IN = 0, MAT_UP0, MAT_WO0, MAT_GU0, MAT_WD0, MAT_W1IN, MAT_WO1, MAT_GU1, MAT_WD1, NMAT };
template <bool RSC>
__device__ __forceinline__ void conv_body(const float* src, int ldw, const float* rs8, float csc, bf16* dst, int Kd, int nsub) {
#pragma unroll
    for (int j = 0; j < 4; ++j) {
        if (j < nsub) {
            f32x4 v[8]; f32x4 r0 = {1.f, 1.f, 1.f, 1.f}, r1 = {1.f, 1.f, 1.f, 1.f};
#pragma unroll
            for (int i = 0; i < 8; ++i) v[i] = __builtin_nontemporal_load((const GAS f32x4*)(src + (size_t)(64 * j + i) * ldw));
            if (RSC) { r0 = *(const GAS f32x4*)(rs8 + 64 * j); r1 = *(const GAS f32x4*)(rs8 + 64 * j + 4); }
            const float sc[8] = {r0[0] * csc, r0[1] * csc, r0[2] * csc, r0[3] * csc, r1[0] * csc, r1[1] * csc, r1[2] * csc, r1[3] * csc};
#pragma unroll
            for (int r = 0; r < 4; ++r) { v4u o; o.x = pk2(v[0][r] * sc[0], v[1][r] * sc[1]); o.y = pk2(v[2][r] * sc[2], v[3][r] * sc[3]); o.z = pk2(v[4][r] * sc[4], v[5][r] * sc[5]); o.w = pk2(v[6][r] * sc[6], v[7][r] * sc[7]);
                pg8::st16(dst + (size_t)r * Kd + 64 * j, o); }
        } else {
#pragma unroll
            for (int r = 0; r < 4; ++r) *(GAS v4u*)(dst + (size_t)r * Kd + 64 * j) = (v4u){0u, 0u, 0u, 0u};
        }
    }
}
__device__ __forceinline__ void conv_task(const Args& a, int mat, int it, int lane) {
    const float* const* in = (const float* const*)a.in; unsigned char* ws = a.ws;
    int Kd = 0, Nd = 0; bf16* WT = nullptr;
    switch (mat) {
        case MAT_W0IN: Kd = 1024; Nd = 2048; WT = (bf16*)(ws + WS_W0IN); break;
        case MAT_UP0:  Kd = 256;  Nd = 1792; WT = (bf16*)(ws + WS_UP0); break;
        case MAT_WO0:  Kd = 1024; Nd = 1024; WT = (bf16*)(ws + WS_WO0); break;
        case MAT_GU0:  Kd = 1024; Nd = 5632; WT = (bf16*)(ws + WS_GU0); break;
        case MAT_WD0:  Kd = 2816; Nd = 1024; WT = (bf16*)(ws + WS_WD0); break;
        case MAT_W1IN: Kd = 1024; Nd = 3072; WT = (bf16*)(ws + WS_W1IN); break;
        case MAT_WO1:  Kd = 1024; Nd = 1024; WT = (bf16*)(ws + WS_WO1); break;
        case MAT_GU1:  Kd = 1024; Nd = 5632; WT = (bf16*)(ws + WS_GU1); break;
        default:       Kd = 2816; Nd = 1024; WT = (bf16*)(ws + WS_WD1); break;
    }
    const int nblk = Nd / 32, kb = it / nblk, nb = it % nblk, k0 = 256 * kb, n0 = 32 * nb;
    const float* W = in[3]; const float* rsc = nullptr; int ldw = 0, col0 = -1, Ksrc = 0; float csc = 1.0f;
    switch (mat) {
        case MAT_W0IN: W = in[3]; ldw = 1952; Ksrc = 1024; rsc = in[2];
            if (n0 < 1536) { col0 = 416 + n0; if (n0 < 512) csc = C2_64; } else if (n0 < 1792) col0 = n0 - 1536; else if (n0 < 1920) col0 = 256 + (n0 - 1792); else if (n0 < 1952) col0 = 384 + (n0 - 1920);
            break;
        case MAT_UP0:
            if (n0 < 768) { W = in[5]; ldw = 768; Ksrc = 256; rsc = in[4]; col0 = n0; }
            else { W = in[7]; ldw = 1024; Ksrc = 128; rsc = in[6]; const int n1 = n0 - 768;
                if (n1 < 512) { const int tp = n1 >> 8, r = n1 & 255, bj = r >> 7, wc = (r >> 5) & 3; col0 = (4 * tp + wc) * 128 + 32 * bj; }
                else { const int n2 = n1 - 512; col0 = (n2 >> 6) * 128 + 64 + (n2 & 63); } }
            break;
        case MAT_WO0: W = in[10]; ldw = 1024; Ksrc = 1024; col0 = n0; break;
        case MAT_GU0: { const int pn = n0 >> 8, r = n0 & 255; W = (r >> 7) ? in[13] : in[12]; ldw = 2816; Ksrc = 1024; rsc = in[11]; col0 = pn * 128 + (r & 127); } break;
        case MAT_WD0: W = in[14]; ldw = 1024; Ksrc = 2816; col0 = n0; break;
        case MAT_W1IN: W = in[16]; ldw = 3088; Ksrc = 1024; rsc = in[15];
            if (n0 < 2048) { const int base = (n0 >= 1024) ? 1024 : 0, n1 = n0 & 1023, pn = n1 >> 8, r = n1 & 255, bj = r >> 7, wc = (r >> 5) & 3; col0 = base + 64 * (4 * pn + wc) + 32 * bj; }
            else col0 = n0;
            break;
        case MAT_WO1: W = in[20]; ldw = 1024; Ksrc = 1024; col0 = n0; break;
        case MAT_GU1: { const int pn = n0 >> 8, r = n0 & 255; W = (r >> 7) ? in[23] : in[22]; ldw = 2816; Ksrc = 1024; rsc = in[21]; col0 = pn * 128 + (r & 127); } break;
        default: W = in[24]; ldw = 1024; Ksrc = 2816; col0 = n0; break;
    }
    const int ng = lane & 7, ks = lane >> 3;
    int nsub = (col0 < 0) ? 0 : (Ksrc - k0) / 64; nsub = nsub < 0 ? 0 : (nsub > 4 ? 4 : nsub);
    if (col0 < 0) col0 = 0;
    const float* src = W + (size_t)(k0 + 8 * ks) * ldw + col0 + 4 * ng;
    bf16* dst = WT + (size_t)(n0 + 4 * ng) * Kd + k0 + 8 * ks;
    if (rsc) conv_body<true>(src, ldw, rsc + k0 + 8 * ks, csc, dst, Kd, nsub); else conv_body<false>(src, ldw, nullptr, csc, dst, Kd, nsub);
}
__device__ __forceinline__ void p0_prologue(Frame& F, const Args& a) {
    const int gw = F.vcu * NWAVES + F.wave, NGW = F.G * NWAVES;
    constexpr int cnt[NMAT] = {64 * 4, 56 * 1, 32 * 4, 176 * 4, 32 * 11, 96 * 4, 32 * 4, 176 * 4, 32 * 11};
    constexpr int NITEMS = cnt[0] + cnt[1] + cnt[2] + cnt[3] + cnt[4] + cnt[5] + cnt[6] + cnt[7] + cnt[8];
    const int per_wg = (NITEMS + F.G - 1) / F.G;
    for (int j = F.wave; j < per_wg; j += NWAVES) {
        const int it = F.vcu * per_wg + j; if (it >= NITEMS) break;
        int r = it, mat = 0;
#pragma unroll
        for (int m = 0; m < NMAT - 1; ++m) { if (mat == m && r >= cnt[m]) { r -= cnt[m]; mat = m + 1; } }
        conv_task(a, mat, r, F.lane);
    }
    { const float* W = (const float*)a.in[16]; const float* g = (const float*)a.in[15]; bf16* WF = (bf16*)(a.ws + WS_WF);
      for (int i = (F.vcu * NWAVES + F.wave) * 64 + F.lane; i < 16 * 1024; i += F.G * NWAVES * 64) { const int j = i >> 10, k = i & 1023; WF[i] = (bf16)f2bf(W[(size_t)k * 3088 + 3072 + j] * g[k]); } }
    { const int* pos = (const int*)a.in[1]; float* RT = (float*)(a.ws + WS_ROPE);
      for (int i = (F.vcu * NWAVES + F.wave) * 64 + F.lane; i < T * 16; i += F.G * NWAVES * 64) { const int t = i >> 4, k = i & 15;
          const float ang = (float)pos[t] * powf(10000.0f, -(float)k / 16.0f); RT[(size_t)t * 32 + k] = cosf(ang); RT[(size_t)t * 32 + 16 + k] = sinf(ang); } }
    { const float* x = (const float*)a.in[0]; bf16* XB = (bf16*)(a.ws + WS_XB); float* ssq = (float*)(a.ws + WS_SSQX);
      for (int m = gw; m < T; m += NGW) {
          const GAS f32x4* xr = (const GAS f32x4*)(x + (size_t)m * D) + F.lane; f32x4 v[4]; float s = 0.f;
#pragma unroll
          for (int j = 0; j < 4; ++j) { v[j] = __builtin_nontemporal_load(xr + 64 * j); s += (v[j].x * v[j].x + v[j].y * v[j].y) + (v[j].z * v[j].z + v[j].w * v[j].w); }
          s = wave_sum(s);
          GAS unsigned long long* o8 = (GAS unsigned long long*)(XB + (size_t)m * D) + F.lane;
#pragma unroll
          for (int j = 0; j < 4; ++j) o8[64 * j] = (unsigned long long)pk2(v[j].x, v[j].y) | ((unsigned long long)pk2(v[j].z, v[j].w) << 32);
          if (F.lane < 4) ssq[(size_t)m * 4 + F.lane] = (F.lane == 0) ? s : 0.f;
      } }
}

__device__ __forceinline__ float fox_mref(const float* qg, const float* kg, int lane_) {
    int lane = lane_; asm volatile("" : "+v"(lane));
    float a = fabsf(qg[lane]), b = fabsf(kg[lane]);
#pragma unroll
    for (int o = 1; o < 64; o <<= 1) { a = fmaxf(a, __shfl_xor(a, o)); b = fmaxf(b, __shfl_xor(b, o)); }
    return 64.0f * C2_64 * a * b * 1.02f + 0.25f;
}
__device__ __forceinline__ float mla_mref(const float* qg, const float* kg, int lane_) {
    int lane = lane_; asm volatile("" : "+v"(lane));
    float a = fmaxf(fabsf(qg[lane]), fabsf(qg[64 + (lane & 31)])), b = fmaxf(fabsf(kg[lane]), fabsf(kg[64 + (lane & 31)]));
#pragma unroll
    for (int o = 1; o < 64; o <<= 1) { a = fmaxf(a, __shfl_xor(a, o)); b = fmaxf(b, __shfl_xor(b, o)); }
    return 96.0f * C2_MLA * a * b * 1.02f + 0.25f;
}
__device__ __forceinline__ void split3(float x, unsigned& h, unsigned& m, unsigned& l) {
    h = f2bf(x); const float r1 = x - __builtin_bit_cast(float, h << 16); m = f2bf(r1); const float r2 = r1 - __builtin_bit_cast(float, m << 16); l = f2bf(r2);
}
__global__ void __launch_bounds__(NWAVES * 64, 2) mk_fwd(Args args) {
    extern __shared__ __attribute__((aligned(16))) unsigned char lds[];
    Frame F;
    F.lds = (LAS unsigned char*)lds;
    F.MISC = (volatile LAS unsigned*)(F.lds + MISC_OFF);
    F.tid = threadIdx.x; F.lane = F.tid & 63; F.wave = __builtin_amdgcn_readfirstlane(F.tid >> 6);
    F.G = gridDim.x; { const int bx = blockIdx.x; F.vcu = (F.G % 8 == 0) ? (bx % 8) * (F.G / 8) + bx / 8 : bx; }
    unsigned char* ws = args.ws;
    F.ctl = (gu32*)(ws + WS_CTL);
    for (int u = F.tid; u < (LDS_BYTES - LDSCTL_OFF) / 4; u += NWAVES * 64) ((LAS unsigned*)(F.lds + LDSCTL_OFF))[u] = 0u;
    __syncthreads();
    XcdBarrier bar; bar.bar = (unsigned*)(F.ctl + CW_BAR) + args.li * XCD_BAR_WORDS; bar.x = 0; bar.st = nullptr;
    if (N_LAUNCHES == 1) bar = xcd_barrier_post((unsigned*)(F.ctl + CW_BAR) + args.li * XCD_BAR_WORDS, F.MISC + 8);
#define GRID_BAR() do { if (N_LAUNCHES == 1) xcd_barrier(bar); } while (0)
    const int lo = args.ph_lo, hi = args.ph_hi;
#ifndef PHASE_MASK
#define PHASE_MASK 0xffff
#endif
#define IN(k) (((PHASE_MASK >> (k)) & 1) && lo <= (k) && (k) < hi)
#define BOTH(k) (IN(k) && IN((k) + 1))
    const float* const* in = (const float* const*)args.in;
    bf16* XB = (bf16*)(ws + WS_XB); bf16* OB = (bf16*)(ws + WS_O);
    float* SSQX = (float*)(ws + WS_SSQX); float* SSQC = (float*)(ws + WS_SSQC); float* SSQKV = (float*)(ws + WS_SSQKV); float* SSQKR = (float*)(ws + WS_SSQKV + 256 * 1024);
    bf16* PROJ0 = (bf16*)(ws + R_PROJ0); bf16* KNOPE = (bf16*)(ws + R_KNOPE); bf16* HB = (bf16*)(ws + R_H);
    bf16* Q1 = (bf16*)(ws + R_Q1); bf16* K1 = (bf16*)(ws + R_K1); bf16* V1 = (bf16*)(ws + R_V1);
    bf16* QM = (bf16*)((unsigned char*)args.out + DO_QM); bf16* KM = (bf16*)((unsigned char*)args.out + DO_KM); bf16* VM = (bf16*)((unsigned char*)args.out + DO_VM);
    float* LOGF = (float*)(ws + WS_LOGF); float* CT = (float*)(ws + WS_DEC); bf16* QAUG = (bf16*)(ws + WS_QAUG); bf16* KAUG = (bf16*)(ws + WS_KAUG);

    if (IN(0)) { p0_prologue(F, args); if (BOTH(0)) GRID_BAR(); }
    if (IN(1)) {
        pg8::Gemm g{XB, (const bf16*)(ws + WS_W0IN), T, 2048, 1024, 1024, 1 << 30, 0}; pg8::StaticOrder S; S.init(T, 2048, F.G, (int)blockIdx.x);
        pg8::EpiProj0 E{PROJ0, (bf16*)(ws + WS_SBK), (bf16*)(ws + WS_SBV), SSQX, SSQC, SSQKV, SSQKR};
        pg8::gemm_phase<pg8::EpiProj0, pg8::StaticOrder, true>(F.lds + RING_OFF, g, S, E);
        if (BOTH(1)) GRID_BAR();
    }
    if (IN(2)) {
        pg8::Gemm g{PROJ0 + 1536, (const bf16*)(ws + WS_UP0), T, 1792, 256, 2048, 3, 256, 2};
        pg8::StaticOrder S; S.init(T, 1792, F.G, (int)blockIdx.x);
        pg8::EpiUp E{QM, KM, VM, SSQC, SSQKV, SSQKR, PROJ0, (const float*)(ws + WS_ROPE), in[9]};
        pg8::gemm_phase<pg8::EpiUp, pg8::StaticOrder, true>(F.lds + RING_OFF, g, S, E);
        if (BOTH(2)) GRID_BAR();
    }
    if (IN(4)) {
        { const float mref = mla_mref(in[8], in[9], F.lane);
          for (int v = F.vcu; v < 256; v += F.G) {
              const int bh = v >> 3, s8 = v & 7, b = bh >> 3, h = bh & 7; const size_t rb = (size_t)b * SEQ;
              att::AttnArgs A{QM + rb * 768 + h * 96, KM + (size_t)bh * 64 * 6144, VM + (size_t)bh * 64 * 4096, OB + rb * 1024 + h * 64, nullptr, nullptr, 768, 768, 512, 1024, 0, mref, (const float*)(ws + WS_ROPE) + rb * 32, in[8], nullptr, nullptr};
              if (__builtin_amdgcn_readfirstlane((int)(mref <= 64.0f))) {
#pragma unroll 1
                  for (int i = 0; i < 2; ++i) att::attn_unit<6, false, true>(A, i == 0 ? s8 : 15 - s8, 0, (char*)lds + RING_OFF);
              } else {
#pragma unroll 1
                  for (int i = 0; i < 2; ++i) att::attn_unit<6, false, false>(A, i == 0 ? s8 : 15 - s8, 0, (char*)lds + RING_OFF);
              }
          } }
        for (int wt = F.vcu; wt < 512; wt += F.G) {
            const int bh = wt >> 4, b = bh >> 3, h = bh & 7, qs = (wt & 15) * 256 + F.wave * 32; const size_t rb = (size_t)b * SEQ;
            att::sb_task(PROJ0 + rb * 2048 + h * 64, (const bf16*)(ws + WS_SBK) + (size_t)bh * 64 * 4096, (const bf16*)(ws + WS_SBV) + (size_t)bh * 64 * 4096, OB + rb * 1024 + 512 + h * 64, qs, (char*)lds + RING_OFF + F.wave * 8192);
        }
        if (BOTH(4)) GRID_BAR();
    }
    if (IN(5)) {
        pg8::Gemm g{OB, (const bf16*)(ws + WS_WO0), T, 1024, 1024, 1024, 1 << 30, 0}; pg8::StaticOrder S; S.init(T, 1024, F.G, (int)blockIdx.x);
        pg8::EpiRes<true, false> E{XB, nullptr, XB, SSQX};
        pg8::gemm_phase<pg8::EpiRes<true, false>, pg8::StaticOrder, false>(F.lds + RING_OFF, g, S, E);
        if (BOTH(5)) GRID_BAR();
    }
    if (IN(6)) {
        pg8::Gemm g{XB, (const bf16*)(ws + WS_GU0), T, 5632, 1024, 1024, 1 << 30, 0}; pg8::HalfTailOrder S; S.init(T, 5632, F.G, (int)blockIdx.x, 4);
        pg8::EpiGU E{HB, SSQX};
        pg8::gemm_phase<pg8::EpiGU, pg8::HalfTailOrder, true>(F.lds + RING_OFF, g, S, E);
        if (BOTH(6)) GRID_BAR();
    }
    if (IN(7)) {
        pg8::Gemm g{HB, (const bf16*)(ws + WS_WD0), T, 1024, 2816, 2816, 1 << 30, 0}; pg8::StaticOrder S; S.init(T, 1024, F.G, (int)blockIdx.x);
        pg8::EpiRes<true, false> E{XB, nullptr, XB, SSQX};
        pg8::gemm_phase<pg8::EpiRes<true, false>, pg8::StaticOrder, false>(F.lds + RING_OFF, g, S, E);
        if (BOTH(7)) GRID_BAR();
    }
    if (IN(8)) {
        {
          const bf16* WF = (const bf16*)(ws + WS_WF); const float* fb = in[17];
          const int fr = F.lane & 15, fq = F.lane >> 4, kh = F.wave & 1, pr = F.wave >> 1;
          LAS f32x4* xch = (LAS f32x4*)(F.lds + RING_OFF);
          for (int rg0 = F.vcu * 4; rg0 < T / 16; rg0 += F.G * 4) {
              const int rg = rg0 + pr;
              const bf16* ap = XB + (size_t)(rg * 16 + fr) * 1024 + 8 * fq + 512 * kh; const bf16* bp = WF + (size_t)fr * 1024 + 8 * fq + 512 * kh;
              pg8::bf16x8 av[16], bv[16];
#pragma unroll
              for (int kk = 0; kk < 16; ++kk) { av[kk] = *(const pg8::bf16x8*)(ap + 32 * kk); bv[kk] = *(const pg8::bf16x8*)(bp + 32 * kk); }
              pg8::f32x4 c = {0.f, 0.f, 0.f, 0.f};
#pragma unroll
              for (int kk = 0; kk < 16; ++kk) c = __builtin_amdgcn_mfma_f32_16x16x32_bf16(av[kk], bv[kk], c, 0, 0, 0);
              if (kh) xch[pr * 64 + F.lane] = c;
              __syncthreads();
              if (!kh) {
                  c += xch[pr * 64 + F.lane];
                  const int row0 = rg * 16 + 4 * fq, b = row0 / SEQ, s0 = row0 % SEQ; const float bias = fb[fr]; f32x4 lf;
#pragma unroll
                  for (int r = 0; r < 4; ++r) { const float xx = c[r] * pg8::rs4(SSQX, row0 + r, 1.0f / 1024.0f) + bias; lf[r] = fminf(xx, 0.f) - log1pf(expf(-fabsf(xx))); }
                  float* dst = LOGF + ((size_t)(b * 16 + fr)) * SEQ + s0;
                  asm volatile("global_store_dwordx4 %0, %1, off sc1" :: "v"(dst), "v"(lf) : "memory");
              }
              asm volatile("s_waitcnt vmcnt(0)" ::: "memory");
              __syncthreads();
              if (F.tid == 0) __hip_atomic_fetch_add((unsigned*)(F.ctl + CW_LOGF + 16 * ((rg0 * 16) / SEQ)), 4u, __ATOMIC_RELAXED, __HIP_MEMORY_SCOPE_AGENT);
          } }
        pg8::Gemm g{XB, (const bf16*)(ws + WS_W1IN), T, 3072, 1024, 1024, 1 << 30, 0}; pg8::StaticOrder S; S.init(T, 3072, F.G, (int)blockIdx.x);
        pg8::EpiProj1 E{Q1, K1, V1, SSQX, in[18], in[19], C2_64, F.lds + RING_OFF + pg8::GAIN_LDS_OFF};
        pg8::gemm_phase<pg8::EpiProj1, pg8::StaticOrder, true>(F.lds + RING_OFF, g, S, E);
    }
    if (IN(9)) {
        LAS float* wsum = (LAS float*)(F.lds + RING_OFF); const float mref9 = fox_mref(in[18], in[19], F.lane);
        for (int u = F.vcu; u < 256; u += F.G) {
            const int sq = u >> 2, part = u & 3, s0 = part * 1024 + F.tid * 2; const float* lf = LOGF + (size_t)sq * SEQ;
            if (BOTH(8)) {
                if (F.tid == 0) { unsigned* cw = (unsigned*)(F.ctl + CW_LOGF + 16 * (sq >> 4)); unsigned sp = 0;
                    while (__hip_atomic_load(cw, __ATOMIC_RELAXED, __HIP_MEMORY_SCOPE_AGENT) < (unsigned)(SEQ / 16)) { __builtin_amdgcn_s_sleep(1); if (++sp > (1u << 22)) break; }
                    __builtin_amdgcn_fence(__ATOMIC_ACQUIRE, "agent"); }
                __syncthreads();
            }
            float pre = 0.f;
            for (int q = 0; q < part; ++q) { const float2 t2 = *(const float2*)(lf + q * 1024 + F.tid * 2); pre += t2.x + t2.y; }
            pre = wave_sum(pre);
            const float2 me = *(const float2*)(lf + s0); const float v0 = me.x, v1 = me.x + me.y;
            float inc = v1;
#pragma unroll
            for (int o = 1; o < 64; o <<= 1) { const float t = __shfl_up(inc, o); if (F.lane >= o) inc += t; }
            if (F.lane == 63) { wsum[F.wave] = inc; wsum[8 + F.wave] = pre; }
            __syncthreads();
            float basev = inc - v1;
            for (int w = 0; w < 8; ++w) { basev += wsum[8 + w]; if (w < F.wave) basev += wsum[w]; }
#pragma unroll
            for (int i = 0; i < 2; ++i) { const float c2 = (basev + (i ? v1 : v0)) * LOG2E; unsigned a0, a1, a2, b0, b1, b2; split3(c2 - mref9, a0, a1, a2); split3(-c2, b0, b1, b2);
                const size_t ro = ((size_t)sq * SEQ + s0 + i) * 8;
                *(v4u*)(QAUG + ro) = (v4u){a0 | (a1 << 16), a2 | 0x3F800000u, 0x3F803F80u, 0u};
                *(v4u*)(KAUG + ro) = (v4u){0x3F803F80u, 0x3F80u | (b0 << 16), b1 | (b2 << 16), 0u};
                if (((s0 + i) & 63) == 63) CT[sq * 64 + ((s0 + i) >> 6)] = c2; }
            __syncthreads();
        }
        if (BOTH(9)) GRID_BAR();
    }
    if (IN(10)) {
        static_assert(att::Lay<6>::LDS_BYTES <= RING_BYTES && att::Lay<5, true>::LDS_BYTES <= RING_BYTES, "attention LDS");
        const float mref = fox_mref(in[18], in[19], F.lane);
        LAS float* ctl_ = (LAS float*)(F.lds + RING_OFF + 98304);
        static_assert(att::Lay<5, true>::LDS_BYTES <= 98304 && 98304 + 16384 <= RING_BYTES, "decay table copy");
        for (int i2 = F.tid; i2 < 1024; i2 += NWAVES * 64) ((LAS f32x4*)ctl_)[i2] = ((const f32x4*)CT)[i2];
        __syncthreads();
        if (F.tid == 0) F.MISC[16] = (unsigned)F.vcu;
        __syncthreads();
        for (;;) {
            const unsigned u = F.MISC[16];
            if (u >= 1024u) break;
            const int qb = 15 - (int)(u >> 6), bh = (int)(u & 63u), b = bh >> 4, h = bh & 15; const size_t rb = (size_t)b * SEQ;
            att::AttnArgs A{Q1 + rb * 1024 + h * 64, K1 + (size_t)bh * 64 * 4096, V1 + (size_t)bh * 64 * 4096, OB + rb * 1024 + h * 64, QAUG + (size_t)bh * SEQ * 8, KAUG + (size_t)bh * SEQ * 8, 1024, 1024, 1024, 1024, 8, mref, nullptr, nullptr, (unsigned*)(F.ctl + CW_Q10), F.MISC + 16};
            const float c2prev = (qb == 0) ? 0.f : ctl_[bh * 64 + 4 * qb - 1];
            const bool skip = (F.lane < 4 * qb) && (c2prev - ctl_[bh * 64 + F.lane] < -136.0f);
            const unsigned long long keep = ~__ballot(skip);
            int tb = (int)__builtin_ctzll(keep) & ~1; tb = tb > 4 * qb ? 4 * qb : tb; tb = __builtin_amdgcn_readfirstlane(tb);
            att::attn_unit<5, true>(A, qb, tb, (char*)lds + RING_OFF);
        }
        if (BOTH(10)) GRID_BAR();
    }
    if (IN(11)) {
        pg8::Gemm g{OB, (const bf16*)(ws + WS_WO1), T, 1024, 1024, 1024, 1 << 30, 0}; pg8::StaticOrder S; S.init(T, 1024, F.G, (int)blockIdx.x);
        pg8::EpiRes<true, false> E{XB, nullptr, XB, SSQX};
        pg8::gemm_phase<pg8::EpiRes<true, false>, pg8::StaticOrder, false>(F.lds + RING_OFF, g, S, E);
        if (BOTH(11)) GRID_BAR();
    }
    if (IN(12)) {
        pg8::Gemm g{XB, (const bf16*)(ws + WS_GU1), T, 5632, 1024, 1024, 1 << 30, 0}; pg8::HalfTailOrder S; S.init(T, 5632, F.G, (int)blockIdx.x, 4);
        pg8::EpiGU E{HB, SSQX};
        pg8::gemm_phase<pg8::EpiGU, pg8::HalfTailOrder, true>(F.lds + RING_OFF, g, S, E);
        if (BOTH(12)) GRID_BAR();
    }
    if (IN(13)) {
        pg8::Gemm g{HB, (const bf16*)(ws + WS_WD1), T, 1024, 2816, 2816, 1 << 30, 0}; pg8::StaticOrder S; S.init(T, 1024, F.G, (int)blockIdx.x);
        pg8::EpiRes<true, true> E{XB, args.out, nullptr, nullptr};
        pg8::gemm_phase<pg8::EpiRes<true, true>, pg8::StaticOrder, false>(F.lds + RING_OFF, g, S, E);
    }
#undef IN
#undef BOTH
}

extern "C" void kernel_launch(void* const* d_in, const int* in_sizes, int n_in, void* d_out, int out_size, void* d_ws, size_t ws_size, hipStream_t stream) {
    static int grid = 0;
    if (grid == 0) {
        if (n_in != 25 || in_sizes[0] != T * D || out_size != T * D || ws_size < WS_END) { fprintf(stderr, "kernel_launch: unexpected shapes (n_in %d, in0 %d, out %d, ws %zu)\n", n_in, n_in > 0 ? in_sizes[0] : -1, out_size, ws_size); grid = -1; return; }
        int dev = 0, cus = 0, per_cu = 0;
        if (hipGetDevice(&dev) != hipSuccess || hipDeviceGetAttribute(&cus, hipDeviceAttributeMultiprocessorCount, dev) != hipSuccess) { grid = -1; return; }
        if (hipFuncSetAttribute((const void*)mk_fwd, hipFuncAttributeMaxDynamicSharedMemorySize, LDS_BYTES) != hipSuccess) { fprintf(stderr, "kernel_launch: hipFuncSetAttribute failed\n"); grid = -1; return; }
        if (hipOccupancyMaxActiveBlocksPerMultiprocessor(&per_cu, (const void*)mk_fwd, NWAVES * 64, LDS_BYTES) != hipSuccess || per_cu < 1) { fprintf(stderr, "kernel_launch: occupancy query says %d blocks per CU\n", per_cu); per_cu = 1; }
        (void)hipGetLastError();
        grid = cus;
    }
    if (grid < 0) return;
    if (hipMemsetAsync((char*)d_ws + WS_CTL, 0, CTL_ZERO_BYTES, stream) != hipSuccess) return;
    Args a{};
    for (int i = 0; i < 25; ++i) a.in[i] = d_in[i];
    a.out = (float*)d_out; a.ws = (unsigned char*)d_ws;
#if defined(PROBE_PHASE)
    { int li = 0; a.ph_lo = 0; a.ph_hi = PROBE_PHASE + 1; a.li = li++; hipLaunchKernelGGL(mk_fwd, dim3(grid), dim3(NWAVES * 64), LDS_BYTES, stream, a);
      for (int r = 0; r < PROBE_REPS - 1; ++r) { a.ph_lo = PROBE_PHASE; a.ph_hi = PROBE_PHASE + 1; a.li = li++; hipLaunchKernelGGL(mk_fwd, dim3(grid), dim3(NWAVES * 64), LDS_BYTES, stream, a); }
      a.ph_lo = PROBE_PHASE; a.ph_hi = NPHASE; a.li = li++; hipLaunchKernelGGL(mk_fwd, dim3(grid), dim3(NWAVES * 64), LDS_BYTES, stream, a); }
#else
    if (N_LAUNCHES == 1) { a.ph_lo = 0; a.ph_hi = NPHASE; hipLaunchKernelGGL(mk_fwd, dim3(grid), dim3(NWAVES * 64), LDS_BYTES, stream, a); }
    else for (int p = 0; p < NPHASE; ++p) { a.ph_lo = p; a.ph_hi = p + 1; hipLaunchKernelGGL(mk_fwd, dim3(grid), dim3(NWAVES * 64), LDS_BYTES, stream, a); }
#endif
}
```
